# Optimizing an MI355X kernel written in HIP

```python
import math
import jax, jax.numpy as jnp
from jax import lax
import numpy as np


D_MODEL = 1024
BATCH = 1
SEQ = 16384
DEPTH = 2
DEC_BATCH = 8
DEC_SEQ = 2048
PAST_LEN = 128

N_MIXERS = 2
S5_GROUP = 16
S5_GROUPS = D_MODEL // S5_GROUP
S5_STATE = 64
S5_DT_MIN = 0.001
S5_DT_MAX = 0.1
POOL_WINDOWS = (2, 4, 8, 16)
POOL_GROUPS = len(POOL_WINDOWS)
POOL_CH = D_MODEL // POOL_GROUPS
D_FF = 2816
RMS_EPS = 1e-6
N_S5_LAYERS = (DEPTH + 1) // 2
N_POOL_LAYERS = DEPTH // 2

kernel_name = 'hybrid_s5_pool_macaron_encoder'


def _rms(x, g):
    xf = x.astype(jnp.float32)
    y = xf * lax.rsqrt(jnp.mean(xf * xf, axis=-1, keepdims=True) + RMS_EPS)
    return (y * g.astype(jnp.float32)).astype(x.dtype)


def _swiglu(x, wg, wu, wd):
    return (jax.nn.silu(x @ wg) * (x @ wu)) @ wd


def _ssm_combine(e1, e2):
    a1r, a1i, b1r, b1i = e1
    a2r, a2i, b2r, b2i = e2
    return (a2r * a1r - a2i * a1i,
            a2r * a1i + a2i * a1r,
            a2r * b1r - a2i * b1i + b2r,
            a2r * b1i + a2i * b1r + b2i)


def _s5_mixer(u, lam_re, lam_im, log_step, b_re, b_im, c_re, c_im, d, w_a, w_b):
    f32 = jnp.float32
    bsz, seq, _ = u.shape
    uf = u.astype(f32)
    ug = uf.reshape(bsz, seq, S5_GROUPS, S5_GROUP)
    y = uf * d.astype(f32)
    for direction in range(2):
        lr = lam_re[direction].astype(f32)
        li = lam_im[direction].astype(f32)
        step = jnp.exp(log_step[direction].astype(f32))[:, None]
        mag = jnp.exp(lr * step)
        ab_re = mag * jnp.cos(li * step)
        ab_im = mag * jnp.sin(li * step)
        den = lr * lr + li * li
        nr = ab_re - 1.0
        k_re = (nr * lr + ab_im * li) / den
        k_im = (ab_im * lr - nr * li) / den
        br = b_re[direction].astype(f32)
        bi = b_im[direction].astype(f32)
        bb_re = k_re[..., None] * br - k_im[..., None] * bi
        bb_im = k_re[..., None] * bi + k_im[..., None] * br
        bu_re = jnp.einsum('blgh,gph->blgp', ug, bb_re)
        bu_im = jnp.einsum('blgh,gph->blgp', ug, bb_im)
        a_re = jnp.broadcast_to(ab_re, bu_re.shape)
        a_im = jnp.broadcast_to(ab_im, bu_im.shape)
        _, _, s_re, s_im = lax.associative_scan(
            _ssm_combine, (a_re, a_im, bu_re, bu_im), reverse=(direction == 1), axis=1)
        y_dir = (jnp.einsum('blgp,ghp->blgh', s_re, c_re[direction].astype(f32))
                 - jnp.einsum('blgp,ghp->blgh', s_im, c_im[direction].astype(f32)))
        y = y + y_dir.reshape(bsz, seq, D_MODEL)
    g = jax.nn.gelu(y).astype(u.dtype)
    return (g @ w_a) * jax.nn.sigmoid(g @ w_b)


def _pool_mixer(u, w, scale):
    f32 = jnp.float32
    bsz, seq, _ = u.shape
    uf = u.astype(f32)
    csum = jnp.concatenate([jnp.zeros((bsz, 1, D_MODEL), f32), lax.cumsum(uf, axis=1)], axis=1)
    pos = jnp.arange(seq)
    parts = []
    for g, win in enumerate(POOL_WINDOWS):
        sl = slice(g * POOL_CH, (g + 1) * POOL_CH)
        lo = jnp.clip(pos - win // 2, 0, seq)
        hi = jnp.clip(pos + win - win // 2, 0, seq)
        cs = csum[..., sl]
        mean = (cs[:, hi] - cs[:, lo]) / (hi - lo).astype(f32)[None, :, None]
        parts.append(mean - uf[..., sl])
    p = jnp.stack(parts, axis=2)
    z = jnp.einsum('blgc,gcd->blgd', p, w.astype(f32)).reshape(bsz, seq, D_MODEL)
    return (z * scale.astype(f32)).astype(u.dtype)


def _trunk(x, norm_g, final_norm_g, ffn_w_gate, ffn_w_up, ffn_w_down,
           s5_lambda_re, s5_lambda_im, s5_log_step, s5_b_re, s5_b_im, s5_c_re, s5_c_im,
           s5_d, s5_w_glu_a, s5_w_glu_b, pool_w, pool_scale):
    for layer in range(DEPTH):
        g = norm_g[layer]
        x = x + 0.5 * _swiglu(_rms(x, g[0]), ffn_w_gate[layer, 0], ffn_w_up[layer, 0], ffn_w_down[layer, 0])
        h = _rms(x, g[1])
        j = layer // N_MIXERS
        if layer % N_MIXERS == 0:
            m = _s5_mixer(h, s5_lambda_re[j], s5_lambda_im[j], s5_log_step[j], s5_b_re[j], s5_b_im[j],
                          s5_c_re[j], s5_c_im[j], s5_d[j], s5_w_glu_a[j], s5_w_glu_b[j])
        else:
            m = _pool_mixer(h, pool_w[j], pool_scale[j])
        x = x + m
        x = x + 0.5 * _swiglu(_rms(x, g[2]), ffn_w_gate[layer, 1], ffn_w_up[layer, 1], ffn_w_down[layer, 1])
    return _rms(x, final_norm_g)


def setup_inputs(seed: int = 0) -> dict:
    key = jax.random.key(seed)
    ks = jax.random.split(key, 20)
    f32 = jnp.float32
    nrm = jax.random.normal
    lam_im_base = jnp.pi * jnp.arange(S5_STATE, dtype=f32)
    return {
        'x_prompt': nrm(ks[0], (BATCH, SEQ, D_MODEL), f32),
        'x_sample': nrm(ks[1], (DEC_BATCH, DEC_SEQ, D_MODEL), f32),
        'norm_g': 1.0 + 0.02 * nrm(ks[2], (DEPTH, 3, D_MODEL), f32),
        'final_norm_g': 1.0 + 0.02 * nrm(ks[3], (D_MODEL,), f32),
        'ffn_w_gate': nrm(ks[4], (DEPTH, 2, D_MODEL, D_FF), f32) * D_MODEL ** -0.5,
        'ffn_w_up': nrm(ks[5], (DEPTH, 2, D_MODEL, D_FF), f32) * D_MODEL ** -0.5,
        'ffn_w_down': nrm(ks[6], (DEPTH, 2, D_FF, D_MODEL), f32) * D_FF ** -0.5,
        's5_lambda_re': -0.5 + 0.01 * nrm(ks[7], (N_S5_LAYERS, 2, S5_GROUPS, S5_STATE), f32),
        's5_lambda_im': lam_im_base + 0.01 * nrm(ks[8], (N_S5_LAYERS, 2, S5_GROUPS, S5_STATE), f32),
        's5_log_step': jax.random.uniform(ks[9], (N_S5_LAYERS, 2, S5_GROUPS), f32,
                                          math.log(S5_DT_MIN), math.log(S5_DT_MAX)),
        's5_b_re': nrm(ks[10], (N_S5_LAYERS, 2, S5_GROUPS, S5_STATE, S5_GROUP), f32) * (2 * S5_GROUP) ** -0.5,
        's5_b_im': nrm(ks[11], (N_S5_LAYERS, 2, S5_GROUPS, S5_STATE, S5_GROUP), f32) * (2 * S5_GROUP) ** -0.5,
        's5_c_re': nrm(ks[12], (N_S5_LAYERS, 2, S5_GROUPS, S5_GROUP, S5_STATE), f32) * 0.5 ** 0.5,
        's5_c_im': nrm(ks[13], (N_S5_LAYERS, 2, S5_GROUPS, S5_GROUP, S5_STATE), f32) * 0.5 ** 0.5,
        's5_d': nrm(ks[14], (N_S5_LAYERS, D_MODEL), f32),
        's5_w_glu_a': nrm(ks[15], (N_S5_LAYERS, D_MODEL, D_MODEL), f32) * D_MODEL ** -0.5,
        's5_w_glu_b': nrm(ks[16], (N_S5_LAYERS, D_MODEL, D_MODEL), f32) * D_MODEL ** -0.5,
        'pool_w': nrm(ks[17], (N_POOL_LAYERS, POOL_GROUPS, POOL_CH, POOL_CH), f32) * POOL_CH ** -0.5,
        'pool_scale': 1.0 + 0.02 * nrm(ks[18], (N_POOL_LAYERS, D_MODEL), f32),
    }


def reference(x_prompt, x_sample, norm_g, final_norm_g, ffn_w_gate, ffn_w_up, ffn_w_down,
              s5_lambda_re, s5_lambda_im, s5_log_step, s5_b_re, s5_b_im, s5_c_re, s5_c_im,
              s5_d, s5_w_glu_a, s5_w_glu_b, pool_w, pool_scale):
    y_prompt = _trunk(x_prompt, norm_g, final_norm_g, ffn_w_gate, ffn_w_up, ffn_w_down,
                      s5_lambda_re, s5_lambda_im, s5_log_step, s5_b_re, s5_b_im, s5_c_re, s5_c_im,
                      s5_d, s5_w_glu_a, s5_w_glu_b, pool_w, pool_scale)
    y_sample = _trunk(x_sample, norm_g, final_norm_g, ffn_w_gate, ffn_w_up, ffn_w_down,
                      s5_lambda_re, s5_lambda_im, s5_log_step, s5_b_re, s5_b_im, s5_c_re, s5_c_im,
                      s5_d, s5_w_glu_a, s5_w_glu_b, pool_w, pool_scale)
    return (y_prompt, y_sample)
```

```cpp
#include <hip/hip_runtime.h>
#include <hip/hip_cooperative_groups.h>
#include <cstdio>
#include <cstddef>
namespace cg = cooperative_groups;

#define LAS __attribute__((address_space(3)))
typedef unsigned short bf16_t;
typedef short bf16x8 __attribute__((ext_vector_type(8)));
typedef float f32x4 __attribute__((ext_vector_type(4)));
typedef float f32x2 __attribute__((ext_vector_type(2)));
typedef unsigned u32x4 __attribute__((ext_vector_type(4)));
typedef unsigned u32x2 __attribute__((ext_vector_type(2)));

#ifndef ONE_LAUNCH
#define ONE_LAUNCH 1
#endif

constexpr int T = 32768, TP = 16384, D = 1024, FF = 2816, NGU = 5632, DSEQ = 2048;
constexpr int LC = 64, NCH = 512, NG = 64;
constexpr float EPS = 1e-6f;
constexpr size_t MiB = 1u << 20;
constexpr size_t OFF_XB = 0, OFF_H = 64 * MiB;
constexpr size_t OFF_SIN = OFF_H, OFF_KC = 266 * MiB, OUT_WC = 64 * MiB, OUT_WEND = 96 * MiB  , OFF_SEND = OFF_H + 84 * MiB, OFF_GACT = OFF_H + 52 * MiB, OFF_PBUF = OFF_H;
constexpr size_t OFF_WGU = 240 * MiB, OFF_WD = 251 * MiB, OFF_WGLU = 256 * MiB + MiB / 2, OFF_WPOOL = 260 * MiB + MiB / 2, OFF_ROWSS = 261 * MiB, OFF_AL = 265 * MiB, OFF_BAR = 265 * MiB + 65536, WS_END = 270 * MiB;
constexpr int LDS_BYTES = 131072 + 2048 + 16, LDS_RS = 131072, LDS_MISC = 131072 + 2048;
constexpr int NPHASE = 18;
#ifndef PROBE
#define PROBE 0
#endif
__host__ __device__ constexpr int nrep(int k) {
    return ((PROBE & 33) && (k == 1 || k == 8 || k == 11 || k == 15)) || ((PROBE & 66) && (k == 2 || k == 9 || k == 12 || k == 16)) || ((PROBE & 4) && (k == 0 || k == 3 || k == 10 || k == 13))
        || ((PROBE & 8) && (k == 4 || k == 5 || k == 6 || k == 7 || k == 14)) ? 2 : 1;
}

struct Params {
    const float* xin0; const float* xin1; const float* norm_g; const float* final_g;
    const float* wg; const float* wu; const float* wd;
    const float* lam_re; const float* lam_im; const float* log_step; const float* b_re; const float* b_im; const float* c_re; const float* c_im;
    const float* s5d; const float* glu_a; const float* glu_b; const float* pool_w; const float* pool_scale;
    float* out; unsigned char* ws; int ph_lo, ph_hi;
};

__device__ __forceinline__ unsigned f2bf(float f) { unsigned u = __builtin_bit_cast(unsigned, f); return (u + 0x7fffu + ((u >> 16) & 1u)) >> 16; }
#if defined(__HIP_DEVICE_COMPILE__)
__device__ __forceinline__ unsigned pk2(float lo, float hi) { unsigned r; asm volatile("v_cvt_pk_bf16_f32 %0, %1, %2" : "=v"(r) : "v"(lo), "v"(hi)); return r; }
#else
__device__ __forceinline__ unsigned pk2(float lo, float hi) { return f2bf(lo) | (f2bf(hi) << 16); }
#endif
__device__ __forceinline__ float fast_sigmoid(float z) { return __builtin_amdgcn_rcpf(1.0f + __expf(-z)); }
__device__ __forceinline__ float wave_sum(float s) {
#pragma unroll
    for (int o = 32; o >= 1; o >>= 1) s += __shfl_xor(s, o);
    return s;
}
__device__ __forceinline__ float row_rstd(const float* rowss, int row, int nq) {
    const f32x4* p = (const f32x4*)(rowss + (size_t)row * 32); float s = 0.f;
    for (int k = 0; k < nq; ++k) { const f32x4 v = p[k]; s += (v[0] + v[1]) + (v[2] + v[3]); }
    return __builtin_amdgcn_rsqf(s * (1.0f / 1024.0f) + EPS);
}

__device__ __forceinline__ int lds_byte(int r, int c) { const int st = (r >> 4) * 2 + (c >> 5), rr = r & 15, cc = c & 31, ob = rr * 64 + cc * 2; return st * 1024 + (ob ^ (((ob >> 9) & 1) << 5)); }
__device__ __forceinline__ void stage_rc(int b, int& R, int& C) { const int st = b / 1024, sb = b % 1024, swz = sb ^ (((sb >> 9) & 1) << 5); R = (st >> 1) * 16 + swz / 64; C = (st & 1) * 32 + (swz % 64) / 2; }
__device__ __forceinline__ int perm32(int rho) { const int n = rho >> 4, i = rho & 15; return 8 * (i >> 2) + 4 * n + (i & 3); }

struct Unit { int pm, pn, g; };
__device__ __forceinline__ int opaque_tid() { int t = threadIdx.x; asm volatile("" : "+v"(t)); return t; }

__device__ __forceinline__ bool order_mn(int L, int nM, int nN, int& pm, int& pn) {
    const int nwg = nM * nN; if (L >= nwg) return false;
    int wgid = L; { const int q = nwg / 8, r = nwg % 8, xcd = wgid % 8, off = wgid / 8; wgid = (xcd < r ? xcd * (q + 1) : r * (q + 1) + (xcd - r) * q) + off; }
    const int nig = 8 * nN, gid = wgid / nig, fm = gid * 8, gsz = (nM - fm) < 8 ? (nM - fm) : 8;
    pm = fm + ((wgid % nig) % gsz); pn = (wgid % nig) / gsz; return true;
}

constexpr int HTB = 128 * 64 * 2;

__device__ __forceinline__ void stage2(LAS unsigned char* dst, const char* g, int v0, int v1) {
    __builtin_amdgcn_global_load_lds((const unsigned*)(g + v0), (LAS unsigned*)dst, 16, 0, 0);
    __builtin_amdgcn_global_load_lds((const unsigned*)(g + v1), (LAS unsigned*)(dst + 8192), 16, 0, 0);
}

template <class P, int MODE = 0>
__device__ __forceinline__ void gemm_phase(LAS unsigned char* lds, const P& p, int G, int c) {
    const int tid = opaque_tid(), wid = __builtin_amdgcn_readfirstlane(tid >> 6), lane = tid & 63, wr = wid >> 2, wc = wid & 3, fr = lane & 15, fq = lane >> 4;
    constexpr int nt = P::NT;
    int voA0, voA1, voB0, voB1, voA20 = 0, voA21 = 0, voB20 = 0, voB21 = 0;
    { int R, C; stage_rc(tid * 16, R, C); int Rb = P::PERM ? ((R & ~31) + perm32(R & 31)) : R; voA0 = p.voffA(R, C); voB0 = p.voffB(Rb, C);
      if constexpr (P::SEG) { voA20 = p.voffA2(R, C); voB20 = p.voffB2(Rb, C); } }
    { int R, C; stage_rc(tid * 16 + 8192, R, C); int Rb = P::PERM ? ((R & ~31) + perm32(R & 31)) : R; voA1 = p.voffA(R, C); voB1 = p.voffB(Rb, C);
      if constexpr (P::SEG) { voA21 = p.voffA2(R, C); voB21 = p.voffB2(Rb, C); } }
    const ptrdiff_t kA = p.kA(), hA = p.hA(), kB = p.kB(), hB = p.hB();
    const ptrdiff_t kA2 = P::SEG ? p.kA2() : 0, hA2 = P::SEG ? p.hA2() : 0, kB2 = P::SEG ? p.kB2() : 0, hB2 = P::SEG ? p.hB2() : 0;
    const unsigned ldsw = (unsigned)wid * 1024u;
    const int aoff = lds_byte(wr * 64 + fr, fq * 8), boff = lds_byte(wc * 32 + fr, fq * 8);
#define G_SA(b, h) (((b) * 2 + (h)) * HTB)
#define G_SB(b, h) ((4 + (b) * 2 + (h)) * HTB)
#define G_STAGE_A(buf, h, b0, b1, tt) do { const bool _s2 = P::SEG && (tt) >= P::TS; \
        const char* _g = _s2 ? (b1) + (ptrdiff_t)((tt) - P::TS) * kA2 + (ptrdiff_t)(h) * hA2 : (b0) + (ptrdiff_t)(tt) * kA + (ptrdiff_t)(h) * hA; \
        stage2(lds + G_SA(buf, h) + ldsw, _g, _s2 ? voA20 : voA0, _s2 ? voA21 : voA1); } while (0)
#define G_STAGE_B(buf, h, b0, b1, tt) do { const bool _s2 = P::SEG && (tt) >= P::TS; \
        const char* _g = _s2 ? (b1) + (ptrdiff_t)((tt) - P::TS) * kB2 + (ptrdiff_t)(h) * hB2 : (b0) + (ptrdiff_t)(tt) * kB + (ptrdiff_t)(h) * hB; \
        stage2(lds + G_SB(buf, h) + ldsw, _g, _s2 ? voB20 : voB0, _s2 ? voB21 : voB1); } while (0)
#define G_LDA(dst, b, h) do { if (MODE != 2) { _Pragma("unroll") for (int m = 0; m < 4; ++m) _Pragma("unroll") for (int k = 0; k < 2; ++k) dst[m][k] = *(const LAS bf16x8*)(lds + G_SA(b, h) + aoff + m * 2048 + k * 1024); } } while (0)
#define G_LDB(dst, b, h) do { if (MODE != 2) { _Pragma("unroll") for (int n = 0; n < 2; ++n) _Pragma("unroll") for (int k = 0; k < 2; ++k) dst[n][k] = *(const LAS bf16x8*)(lds + G_SB(b, h) + boff + n * 2048 + k * 1024); } } while (0)
#define G_MMA(ai, bj, At, Bt, Z) do { if (MODE == 1) { _Pragma("unroll") for (int m = 0; m < 4; ++m) _Pragma("unroll") for (int k = 0; k < 2; ++k) asm volatile("" :: "v"(At[m][k])); \
            _Pragma("unroll") for (int n = 0; n < 2; ++n) _Pragma("unroll") for (int k = 0; k < 2; ++k) asm volatile("" :: "v"(Bt[n][k])); } else { \
        __builtin_amdgcn_s_setprio(1); \
        _Pragma("unroll") for (int m = 0; m < 4; ++m) _Pragma("unroll") for (int n = 0; n < 2; ++n) \
            acc[ai][bj][m][n] = __builtin_amdgcn_mfma_f32_16x16x32_bf16(Bt[n][0], At[m][0], (Z) ? (f32x4){0.f, 0.f, 0.f, 0.f} : acc[ai][bj][m][n], 0, 0, 0); \
        _Pragma("unroll") for (int m = 0; m < 4; ++m) _Pragma("unroll") for (int n = 0; n < 2; ++n) \
            acc[ai][bj][m][n] = __builtin_amdgcn_mfma_f32_16x16x32_bf16(Bt[n][1], At[m][1], acc[ai][bj][m][n], 0, 0, 0); \
        __builtin_amdgcn_s_setprio(0); } } while (0)
#define G_WAIT_V(n) asm volatile("s_waitcnt vmcnt(" #n ")" ::: "memory")
#define G_WAIT_L(n) asm volatile("s_waitcnt lgkmcnt(" #n ")" ::: "memory")
#define G_BAR __builtin_amdgcn_s_barrier()
#define G_SCHED __builtin_amdgcn_sched_barrier(0)
    Unit cur, nxt; int ui = 0;
    if (!p.unit(c, cur)) return;
    f32x4 acc[2][2][4][2];
    bf16x8 At[4][2], B0[2][2], B1[2][2];
    if (MODE == 2) {
#pragma unroll
        for (int m = 0; m < 4; ++m)
#pragma unroll
            for (int k = 0; k < 2; ++k) { At[m][k] = (bf16x8){(short)(0x3c00 + fr), 0x3f80, (short)0xbf80, 0x3e00, (short)(0x3d00 + fq), 0x3f00, (short)0xbe80, 0x3f80}; asm volatile("" : "+v"(At[m][k])); }
#pragma unroll
        for (int n = 0; n < 2; ++n)
#pragma unroll
            for (int k = 0; k < 2; ++k) { B0[n][k] = At[n][k]; B1[n][k] = At[n + 2][k]; asm volatile("" : "+v"(B0[n][k])); asm volatile("" : "+v"(B1[n][k])); }
    }
    const char* cA = p.a0(cur); const char* cB = p.b0(cur);
    const char* cA2 = P::SEG ? p.a1(cur) : cA; const char* cB2 = P::SEG ? p.b1(cur) : cB;
    G_STAGE_B(0, 0, cB, cB2, 0); G_STAGE_A(0, 0, cA, cA2, 0); G_STAGE_B(0, 1, cB, cB2, 0); G_STAGE_A(0, 1, cA, cA2, 0);
    if (wr == 1) G_BAR;
    G_WAIT_V(4); G_BAR;
    G_STAGE_B(1, 0, cB, cB2, 1); G_STAGE_A(1, 0, cA, cA2, 1); G_STAGE_B(1, 1, cB, cB2, 1);
    G_WAIT_V(6); G_BAR;
    for (;;) {
        const bool has_next = p.unit((ui + 1) * G + c, nxt);
        const char* nA = has_next ? p.a0(nxt) : cA; const char* nB = has_next ? p.b0(nxt) : cB;
        const char* nA2 = P::SEG ? (has_next ? p.a1(nxt) : cA2) : nA; const char* nB2 = P::SEG ? (has_next ? p.b1(nxt) : cB2) : nB;
#define G_PAIR(t, Z) do { \
            const bool last = ((t) == nt - 2); \
            const char* xA = last ? nA : cA; const char* xA2 = last ? nA2 : cA2; const char* xB = last ? nB : cB; const char* xB2 = last ? nB2 : cB2; \
            const int t2 = last ? 0 : (t) + 2, t3 = t2 + 1; \
              G_LDB(B0, 0, 0); G_SCHED; G_LDA(At, 0, 0); G_STAGE_A(1, 1, cA, cA2, (t) + 1); \
            G_WAIT_L(8); G_BAR; G_WAIT_L(0); G_MMA(0, 0, At, B0, Z); G_BAR; G_SCHED; \
              G_LDB(B1, 0, 1); G_STAGE_B(0, 0, xB, xB2, t2); \
            G_BAR; G_WAIT_L(0); G_MMA(0, 1, At, B1, Z); G_BAR; \
              G_LDA(At, 0, 1); G_STAGE_A(0, 0, xA, xA2, t2); \
            G_BAR; G_WAIT_L(0); G_MMA(1, 0, At, B0, Z); G_BAR; G_SCHED; \
              G_STAGE_B(0, 1, xB, xB2, t2); \
            G_WAIT_V(6); G_BAR; G_MMA(1, 1, At, B1, Z); G_BAR; \
              G_LDB(B0, 1, 0); G_SCHED; G_LDA(At, 1, 0); G_STAGE_A(0, 1, xA, xA2, t2); \
            G_WAIT_L(8); G_BAR; G_WAIT_L(0); G_MMA(0, 0, At, B0, 0); G_BAR; G_SCHED; \
              G_LDB(B1, 1, 1); G_STAGE_B(1, 0, xB, xB2, t3); \
            G_BAR; G_WAIT_L(0); G_MMA(0, 1, At, B1, 0); G_BAR; \
              G_LDA(At, 1, 1); G_STAGE_A(1, 0, xA, xA2, t3); \
            G_BAR; G_WAIT_L(0); G_MMA(1, 0, At, B0, 0); G_BAR; G_SCHED; \
              G_STAGE_B(1, 1, xB, xB2, t3); \
            G_WAIT_V(6); G_BAR; G_MMA(1, 1, At, B1, 0); G_BAR; } while (0)
        G_PAIR(0, 1);
#pragma unroll 1
        for (int t = 2; t < nt; t += 2) G_PAIR(t, 0);
        p.epi(acc, cur, wr, wc, fr, fq);
        if (!has_next) break;
        cur = nxt; cA = nA; cB = nB; cA2 = nA2; cB2 = nB2; ++ui;
    }
    G_WAIT_V(0);
    if (wr == 0) G_BAR;
    G_BAR;
#undef G_SA
#undef G_SB
#undef G_STAGE_A
#undef G_STAGE_B
#undef G_LDA
#undef G_LDB
#undef G_MMA
#undef G_PAIR
#undef G_WAIT_V
#undef G_WAIT_L
#undef G_BAR
#undef G_SCHED
}

struct ConvJob { const float* s0; ptrdiff_t d10; const float* gain; bf16_t* dst; int kind; int pad; };
__device__ __forceinline__ void conv_load(const float* src, int stride, float (&v)[8]) {
#pragma unroll
    for (int j = 0; j < 8; ++j) v[j] = src[(size_t)j * stride];
}
__device__ __forceinline__ void conv_store(bf16_t* dst, const float (&v)[8], const float* kgain, float nscale) {
    float g[8];
#pragma unroll
    for (int j = 0; j < 8; ++j) g[j] = kgain ? kgain[j] * nscale : nscale;
    u32x4 w; w.x = pk2(v[0] * g[0], v[1] * g[1]); w.y = pk2(v[2] * g[2], v[3] * g[3]); w.z = pk2(v[4] * g[4], v[5] * g[5]); w.w = pk2(v[6] * g[6], v[7] * g[7]);
    *(u32x4*)dst = w;
}
constexpr int NWI_GU = 88 * 128, NWI_DN = 16 * 352, NWI_GLU = 32 * 128, NWI_POOL = 16 * 32;
__device__ __forceinline__ void conv_addr(const ConvJob& j, int wi, int lane, const float*& src, int& stride, bf16_t*& dst, const float*& kg) {
    if (j.kind == 1) { const int rb = wi >> 7, k0 = (wi & 127) * 8, pn = rb >> 2, bj = (rb >> 1) & 1;
        src = j.s0 + (ptrdiff_t)bj * j.d10 + (size_t)k0 * FF + pn * 128 + (rb & 1) * 64 + lane; stride = FF; dst = j.dst + (size_t)(rb * 64 + lane) * D + k0; kg = j.gain + k0; }
    else { const int nb = wi / 352, k0 = (wi - nb * 352) * 8;
        src = j.s0 + (size_t)k0 * D + nb * 64 + lane; stride = D; dst = j.dst + (size_t)(nb * 64 + lane) * FF + k0; kg = nullptr; }
}
__device__ __forceinline__ ConvJob job_gu(const Params& P, int layer, int f) { ConvJob j; const size_t wo = ((size_t)layer * 2 + f) * (size_t)D * FF;
    j.s0 = P.wg + wo; j.d10 = P.wu - P.wg; j.gain = P.norm_g + ((size_t)layer * 3 + (f ? 2 : 0)) * D; j.dst = (bf16_t*)(P.ws + OFF_WGU); j.kind = 1; j.pad = 0; return j; }
__device__ __forceinline__ ConvJob job_dn(const Params& P, int layer, int f) { ConvJob j; const size_t wo = ((size_t)layer * 2 + f) * (size_t)D * FF;
    j.s0 = P.wd + wo; j.d10 = 0; j.gain = nullptr; j.dst = (bf16_t*)(P.ws + OFF_WD); j.kind = 2; j.pad = 0; return j; }
__device__ __forceinline__ ConvJob job_none() { ConvJob j; j.s0 = nullptr; j.d10 = 0; j.gain = nullptr; j.dst = nullptr; j.kind = 0; j.pad = 0; return j; }
template <int NJ>
struct ConvHost {
    float v[NJ][8]; bf16_t* dst[NJ]; const float* kg[NJ]; bool on[NJ];
    __device__ __forceinline__ void begin(const ConvJob& j, int L, int per, int wid, int lane) {
#pragma unroll
        for (int q = 0; q < NJ; ++q) { on[q] = j.kind != 0 && (wid + 8 * q) < per;
            if (on[q]) { const float* src; int stride; conv_addr(j, L * per + wid + 8 * q, lane, src, stride, dst[q], kg[q]); conv_load(src, stride, v[q]); } }
    }
    __device__ __forceinline__ void finish() {
#pragma unroll
        for (int q = 0; q < NJ; ++q) if (on[q]) conv_store(dst[q], v[q], kg[q], 1.0f);
    }
};

template <int NMAX>
__device__ __forceinline__ void conv_block(const ConvJob& j, int total, int gw, int NW, int lane) {
    if (j.kind == 0) return;
    float v[NMAX][8]; bf16_t* d[NMAX]; const float* kg[NMAX];
#pragma unroll
    for (int q = 0; q < NMAX; ++q) { const int wi = gw + q * NW; const float* src; int st;
        conv_addr(j, wi < total ? wi : gw, lane, src, st, d[q], kg[q]); conv_load(src, st, v[q]); }
#pragma unroll
    for (int q = 0; q < NMAX; ++q) if (gw + q * NW < total) conv_store(d[q], v[q], kg[q], 1.0f);
}

__device__ __forceinline__ void dry_epi(const f32x4 (&acc)[2][2][4][2], int flag, float* sink) {
    if (flag == 12345) { f32x4 s = (f32x4){0.f, 0.f, 0.f, 0.f};
#pragma unroll
        for (int a = 0; a < 2; ++a)
#pragma unroll
            for (int b = 0; b < 2; ++b)
#pragma unroll
                for (int m = 0; m < 4; ++m)
#pragma unroll
                    for (int n = 0; n < 2; ++n) s += acc[a][b][m][n];
        *(f32x4*)(sink + threadIdx.x * 4) = s; }
}
template <int LDA, int LDB, int NT_, bool PERM_>
struct PlainBase {
    static constexpr bool PERM = PERM_, SEG = false; static constexpr int NT = NT_, TS = 0;
    __device__ __forceinline__ ptrdiff_t kA() const { return 128; }
    __device__ __forceinline__ ptrdiff_t hA() const { return (ptrdiff_t)128 * LDA * 2; }
    __device__ __forceinline__ ptrdiff_t kB() const { return 128; }
    __device__ __forceinline__ ptrdiff_t hB() const { return (ptrdiff_t)128 * LDB * 2; }
    __device__ __forceinline__ ptrdiff_t kA2() const { return 0; }
    __device__ __forceinline__ ptrdiff_t hA2() const { return 0; }
    __device__ __forceinline__ ptrdiff_t kB2() const { return 0; }
    __device__ __forceinline__ ptrdiff_t hB2() const { return 0; }
    __device__ __forceinline__ int voffA(int R, int C) const { return (R * LDA + C) * 2; }
    __device__ __forceinline__ int voffB(int R, int C) const { return (R * LDB + C) * 2; }
    __device__ __forceinline__ int voffA2(int, int) const { return 0; }
    __device__ __forceinline__ int voffB2(int, int) const { return 0; }
    __device__ __forceinline__ const char* a1(const Unit&) const { return nullptr; }
    __device__ __forceinline__ const char* b1(const Unit&) const { return nullptr; }
};

struct GemmGU : PlainBase<D, D, 16, true> {
    const char* A; const char* B; bf16_t* H; const LAS float* rs_lds; int nq; int dry; ConvJob cj;
    __device__ __forceinline__ bool unit(int L, Unit& u) const { u.g = L; return order_mn(L, T / 256, NGU / 256, u.pm, u.pn); }
    __device__ __forceinline__ const char* a0(const Unit& u) const { return A + (((PROBE & 128) && dry) ? 0 : (size_t)u.pm * 256 * D * 2); }
    __device__ __forceinline__ const char* b0(const Unit& u) const { return B + (((PROBE & 128) && dry) ? 0 : (size_t)u.pn * 256 * D * 2); }
    __device__ __forceinline__ void epi(const f32x4 (&acc)[2][2][4][2], const Unit& u, int wr, int wc, int fr, int fq) const {
        if ((PROBE & 32) && dry) { dry_epi(acc, nq, (float*)H); return; }
        ConvHost<1> ch; ch.begin(cj, u.g, 2, wr * 4 + wc, fq * 16 + fr);
        const int row0 = u.pm * 256 + wr * 64 + fr, col0 = u.pn * 128 + wc * 32 + 8 * fq;
#pragma unroll
        for (int ai = 0; ai < 2; ++ai)
#pragma unroll
            for (int m = 0; m < 4; ++m) {
                const int row = row0 + ai * 128 + m * 16; const float rs = rs_lds[((u.pm >> 3) & 1) * 256 + (row & 255)];
                const float rs2 = rs * -1.4426950408889634f, rsq = rs * rs;
                f32x2 v[4];
#pragma unroll
                for (int n = 0; n < 2; ++n)
#pragma unroll
                    for (int jp = 0; jp < 2; ++jp) {
                        const f32x2 gg = (f32x2){acc[ai][0][m][n][2 * jp], acc[ai][0][m][n][2 * jp + 1]}, uu = (f32x2){acc[ai][1][m][n][2 * jp], acc[ai][1][m][n][2 * jp + 1]};
                        const f32x2 t = gg * rs2; f32x2 e; e.x = __builtin_amdgcn_exp2f(t.x); e.y = __builtin_amdgcn_exp2f(t.y);
                        const f32x2 d = e + 1.0f; f32x2 r; r.x = __builtin_amdgcn_rcpf(d.x); r.y = __builtin_amdgcn_rcpf(d.y);
                        v[n * 2 + jp] = (gg * uu) * (r * rsq);
                    }
                u32x4 w; w.x = pk2(v[0].x, v[0].y); w.y = pk2(v[1].x, v[1].y); w.z = pk2(v[2].x, v[2].y); w.w = pk2(v[3].x, v[3].y);
                *(u32x4*)(H + (size_t)row * FF + col0) = w;
            }
        ch.finish();
    }
};

__device__ __forceinline__ float bf_lo(unsigned w) { return __builtin_bit_cast(float, w << 16); }
__device__ __forceinline__ float bf_hi(unsigned w) { return __builtin_bit_cast(float, w & 0xffff0000u); }
template <int LDA, int LDB, int NT_>
struct GemmResid : PlainBase<LDA, LDB, NT_, true> {
    const char* A; const char* B; bf16_t* xb; float* rowss; float coef; int pool; ConvJob cj;
    __device__ __forceinline__ bool unit(int L, Unit& u) const { u.g = L; return order_mn(L, T / 256, D / 256, u.pm, u.pn); }
    __device__ __forceinline__ const char* a0(const Unit& u) const { return A + ((size_t)u.pm * 256 * LDA + (pool ? (size_t)u.pn * 256 : 0)) * 2; }
    __device__ __forceinline__ const char* b0(const Unit& u) const { return B + (size_t)u.pn * 256 * LDB * 2; }
    __device__ __forceinline__ void epi(const f32x4 (&acc)[2][2][4][2], const Unit& u, int wr, int wc, int fr, int fq) const {
        if ((PROBE & 64) && coef == 0.f) { dry_epi(acc, pool, rowss); return; }
        ConvHost<3> ch; ch.begin(cj, u.g, 22, wr * 4 + wc, fq * 16 + fr);
        const int row0 = u.pm * 256 + wr * 64 + fr, col0 = u.pn * 256 + wc * 32 + 8 * fq;
#pragma unroll
        for (int ai = 0; ai < 2; ++ai) {
            u32x4 xo[4][2];
#pragma unroll
            for (int m = 0; m < 4; ++m)
#pragma unroll
                for (int bj = 0; bj < 2; ++bj) xo[m][bj] = *(const u32x4*)(xb + (size_t)(row0 + ai * 128 + m * 16) * D + col0 + bj * 128);
#pragma unroll
            for (int m = 0; m < 4; ++m) {
                const int row = row0 + ai * 128 + m * 16; const size_t off = (size_t)row * D + col0; float ss = 0.f;
#pragma unroll
                for (int bj = 0; bj < 2; ++bj) {
                    const u32x4 o = xo[m][bj]; const f32x4 a0v = acc[ai][bj][m][0], a1v = acc[ai][bj][m][1];
                    const float v0 = bf_lo(o.x) + coef * a0v[0], v1 = bf_hi(o.x) + coef * a0v[1], v2 = bf_lo(o.y) + coef * a0v[2], v3 = bf_hi(o.y) + coef * a0v[3];
                    const float v4 = bf_lo(o.z) + coef * a1v[0], v5 = bf_hi(o.z) + coef * a1v[1], v6 = bf_lo(o.w) + coef * a1v[2], v7 = bf_hi(o.w) + coef * a1v[3];
                    u32x4 w; w.x = pk2(v0, v1); w.y = pk2(v2, v3); w.z = pk2(v4, v5); w.w = pk2(v6, v7);
                    *(u32x4*)(xb + off + bj * 128) = w;
                    ss += ((v0 * v0 + v1 * v1) + (v2 * v2 + v3 * v3)) + ((v4 * v4 + v5 * v5) + (v6 * v6 + v7 * v7));
                }
                ss += __shfl_xor(ss, 16); ss += __shfl_xor(ss, 32);
                if (fq == 0) rowss[(size_t)row * 32 + u.pn * 4 + wc] = ss;
            }
            asm volatile("" ::: "memory");
        }
        ch.finish();
    }
};

struct GemmGLU : PlainBase<D, D, 16, true> {
    const char* A; const char* B; bf16_t* xb; float* rowss; float coef;
    __device__ __forceinline__ bool unit(int L, Unit& u) const { u.g = 0; return order_mn(L, T / 256, 8, u.pm, u.pn); }
    __device__ __forceinline__ const char* a0(const Unit& u) const { return A + (size_t)u.pm * 256 * D * 2; }
    __device__ __forceinline__ const char* b0(const Unit& u) const { return B + (size_t)u.pn * 256 * D * 2; }
    __device__ __forceinline__ void epi(const f32x4 (&acc)[2][2][4][2], const Unit& u, int wr, int wc, int fr, int fq) const {
        const int row0 = u.pm * 256 + wr * 64 + fr, col0 = u.pn * 128 + wc * 32 + 8 * fq;
#pragma unroll
        for (int ai = 0; ai < 2; ++ai) {
            u32x4 xo[4];
#pragma unroll
            for (int m = 0; m < 4; ++m) xo[m] = *(const u32x4*)(xb + (size_t)(row0 + ai * 128 + m * 16) * D + col0);
#pragma unroll
            for (int m = 0; m < 4; ++m) {
                const int row = row0 + ai * 128 + m * 16; const size_t off = (size_t)row * D + col0;
                const u32x4 o = xo[m]; const f32x4 a0v = acc[ai][0][m][0], a1v = acc[ai][0][m][1], b0v = acc[ai][1][m][0], b1v = acc[ai][1][m][1];
                const float v0 = bf_lo(o.x) + coef * a0v[0] * fast_sigmoid(b0v[0]), v1 = bf_hi(o.x) + coef * a0v[1] * fast_sigmoid(b0v[1]);
                const float v2 = bf_lo(o.y) + coef * a0v[2] * fast_sigmoid(b0v[2]), v3 = bf_hi(o.y) + coef * a0v[3] * fast_sigmoid(b0v[3]);
                const float v4 = bf_lo(o.z) + coef * a1v[0] * fast_sigmoid(b1v[0]), v5 = bf_hi(o.z) + coef * a1v[1] * fast_sigmoid(b1v[1]);
                const float v6 = bf_lo(o.w) + coef * a1v[2] * fast_sigmoid(b1v[2]), v7 = bf_hi(o.w) + coef * a1v[3] * fast_sigmoid(b1v[3]);
                u32x4 w; w.x = pk2(v0, v1); w.y = pk2(v2, v3); w.z = pk2(v4, v5); w.w = pk2(v6, v7);
                *(u32x4*)(xb + off) = w;
                float ss = ((v0 * v0 + v1 * v1) + (v2 * v2 + v3 * v3)) + ((v4 * v4 + v5 * v5) + (v6 * v6 + v7 * v7));
                ss += __shfl_xor(ss, 16); ss += __shfl_xor(ss, 32);
                if (fq == 0) rowss[(size_t)row * 32 + u.pn * 4 + wc] = ss;
            }
            asm volatile("" ::: "memory");
        }
    }
};

struct GemmSend : PlainBase<D, D, 8, false> {
    const char* A; const char* B; float* Send;
    __device__ __forceinline__ bool unit(int L, Unit& u) const { if (L >= NG * 4) return false; u.g = L >> 2; u.pm = (L >> 1) & 1; u.pn = L & 1; return true; }
    __device__ __forceinline__ const char* a0(const Unit& u) const { return A + (((size_t)u.g * NCH + u.pm * 256) * D + u.pn * 512) * 2; }
    __device__ __forceinline__ const char* b0(const Unit& u) const { return B + ((size_t)u.g * 256 * D + u.pn * 512) * 2; }
    __device__ __forceinline__ void epi(const f32x4 (&acc)[2][2][4][2], const Unit& u, int wr, int wc, int fr, int fq) const {
        const int row0 = u.pm * 256 + wr * 64 + fr, col0 = wc * 32 + 4 * fq;
#pragma unroll
        for (int ai = 0; ai < 2; ++ai)
#pragma unroll
            for (int m = 0; m < 4; ++m) {
                float* rowp = Send + (size_t)u.pn * NG * NCH * 256 + ((size_t)u.g * NCH + row0 + ai * 128 + m * 16) * 256 + col0;
#pragma unroll
                for (int bj = 0; bj < 2; ++bj)
#pragma unroll
                    for (int n = 0; n < 2; ++n) *(f32x4*)(rowp + bj * 128 + n * 16) = acc[ai][bj][m][n];
            }
    }
};

struct GemmToep {
    static constexpr bool PERM = true, SEG = true; static constexpr int NT = 20, TS = 16;
    const char* Ug; const char* Sin; const char* Kc; const char* Wc; bf16_t* gact;
    __device__ __forceinline__ ptrdiff_t kA() const { return 128; }
    __device__ __forceinline__ ptrdiff_t hA() const { return (ptrdiff_t)128 * D * 2; }
    __device__ __forceinline__ ptrdiff_t kB() const { return -2048; }
    __device__ __forceinline__ ptrdiff_t hB() const { return 4096; }
    __device__ __forceinline__ ptrdiff_t kA2() const { return 128; }
    __device__ __forceinline__ ptrdiff_t hA2() const { return (ptrdiff_t)128 * 256 * 2; }
    __device__ __forceinline__ ptrdiff_t kB2() const { return 128; }
    __device__ __forceinline__ ptrdiff_t hB2() const { return (ptrdiff_t)128 * 256 * 2; }
    __device__ __forceinline__ int voffA(int R, int C) const { return (R * D + C) * 2; }
    __device__ __forceinline__ int voffB(int R, int C) const { return (((R >> 4) - (C >> 4)) * 256 + (R & 15) * 16 + (C & 15)) * 2; }
    __device__ __forceinline__ int voffA2(int R, int C) const { return (R * 256 + C) * 2; }
    __device__ __forceinline__ int voffB2(int R, int C) const { return (R * 256 + C) * 2; }
    __device__ __forceinline__ bool unit(int L, Unit& u) const { if (L >= NG * 8) return false; u.g = L >> 3; u.pm = (L >> 2) & 1; u.pn = L & 3; return true; }
    __device__ __forceinline__ const char* a0(const Unit& u) const { return Ug + ((size_t)u.g * NCH + u.pm * 256) * D * 2; }
    __device__ __forceinline__ const char* a1(const Unit& u) const { return Sin + ((size_t)u.g * NCH + u.pm * 256) * 256 * 2; }
    __device__ __forceinline__ const char* b0(const Unit& u) const { return Kc + ((size_t)u.g * 127 + 16 * u.pn + 63) * 512; }
    __device__ __forceinline__ const char* b1(const Unit& u) const { return Wc + ((size_t)u.g * 1024 + u.pn * 256) * 256 * 2; }
    __device__ __forceinline__ void epi(const f32x4 (&acc)[2][2][4][2], const Unit& u, int wr, int wc, int fr, int fq) const {
        const int ch0 = u.pm * 256 + wr * 64 + fr;
#pragma unroll
        for (int ai = 0; ai < 2; ++ai)
#pragma unroll
            for (int m = 0; m < 4; ++m) {
                const int chunk = ch0 + ai * 128 + m * 16;
#pragma unroll
                for (int bj = 0; bj < 2; ++bj) {
                    const int tl = 16 * u.pn + 8 * bj + 2 * wc + (fq >> 1);
                    float v[8];
#pragma unroll
                    for (int n = 0; n < 2; ++n)
#pragma unroll
                        for (int j = 0; j < 4; ++j) { const float y = acc[ai][bj][m][n][j]; v[n * 4 + j] = y * fast_sigmoid(1.5957691216f * (y + 0.044715f * y * y * y)); }
                    u32x4 w; w.x = pk2(v[0], v[1]); w.y = pk2(v[2], v[3]); w.z = pk2(v[4], v[5]); w.w = pk2(v[6], v[7]);
                    *(u32x4*)(gact + ((size_t)chunk * LC + tl) * D + u.g * 16 + 8 * (fq & 1)) = w;
                }
            }
    }
};

__device__ __forceinline__ void sincos_d(double ang, double& s, double& c) {
    const double k = rint(ang * 0.15915494309189533577); const double r = fma(-k, 6.283185307179586476925, ang); const double r2 = r * r;
    double ts = r, tc = 1.0; s = r; c = 1.0;
#pragma unroll
    for (int n = 1; n <= 14; ++n) { tc *= -r2 * (1.0 / (double)((2 * n - 1) * (2 * n))); c += tc; ts *= -r2 * (1.0 / (double)((2 * n) * (2 * n + 1))); s += ts; }
}
__device__ __forceinline__ void s5_tables(const Params& P, int g, int part, unsigned char* lds) {
    f32x2* pw = (f32x2*)lds; f32x2* Chp = (f32x2*)(lds + 67584); f32x2* Cph = (f32x2*)(lds + 83968); f32x2* Bb = (f32x2*)(lds + 100352); f32x2* kf = (f32x2*)(lds + 116736);
    const int tid = threadIdx.x;
    {
        const int dir = tid >> 8, p = (tid >> 2) & 63, q = tid & 3;
        const double lr = (double)P.lam_re[(dir * NG + g) * 64 + p], li = (double)P.lam_im[(dir * NG + g) * 64 + p], step = exp((double)P.log_step[dir * NG + g]);
        const double zr = lr * step, th = li * step;
        for (int e = q; e <= 64; e += 4) { double s, c; sincos_d(th * e, s, c); const double mag = exp(zr * e); pw[(dir * 64 + p) * 66 + e] = (f32x2){(float)(mag * c), (float)(mag * s)}; }
        if (q == 0) { double s, c; sincos_d(th, s, c); const double mag = exp(zr), ar = mag * c, ai = mag * s, nr = ar - 1.0, den = lr * lr + li * li;
            kf[dir * 64 + p] = (f32x2){(float)((nr * lr + ai * li) / den), (float)((ai * lr - nr * li) / den)}; }
    }
    __syncthreads();
    for (int i = tid; i < 2048; i += 512) {
        const int dir = i >> 10, p = (i >> 4) & 63, h = i & 15;
        const size_t bi = (((size_t)dir * NG + g) * 64 + p) * 16 + h;
        const f32x2 k = kf[dir * 64 + p]; const float br = P.b_re[bi], bim = P.b_im[bi];
        Bb[(dir * 64 + p) * 16 + h] = (f32x2){k.x * br - k.y * bim, k.x * bim + k.y * br};
        const size_t ci = (((size_t)dir * NG + g) * 16 + h) * 64 + p;
        const f32x2 cv = (f32x2){P.c_re[ci], P.c_im[ci]};
        Chp[(dir * 16 + h) * 64 + p] = cv; Cph[(dir * 64 + p) * 16 + h] = cv;
    }
    __syncthreads();
    if (part < 2) {
        bf16_t* Kc = (bf16_t*)(P.ws + OFF_KC) + (size_t)g * 127 * 256;
        if (part == 0 && tid < 128) { const int dir = tid >> 6, p = tid & 63; ((f32x2*)(P.ws + OFF_AL))[(g * 2 + dir) * 64 + p] = pw[(dir * 64 + p) * 66 + 64]; }
        const int jbase = part ? 64 : 0, nitem = part ? 63 * 16 : 64 * 16;
        for (int idx = tid; idx < nitem; idx += 512) {
            const int jj = jbase + (idx >> 4), h = idx & 15, j = jj - 63;
            float a[16];
#pragma unroll
            for (int k = 0; k < 16; ++k) a[k] = 0.f;
            if (j >= 0) {
                for (int p = 0; p < 64; ++p) { const f32x2 cv = Cph[p * 16 + h], w = pw[p * 66 + j]; const float cwr = cv.x * w.x - cv.y * w.y, cwi = cv.x * w.y + cv.y * w.x;
#pragma unroll
                    for (int k = 0; k < 16; ++k) { const f32x2 b = Bb[p * 16 + k]; a[k] += cwr * b.x - cwi * b.y; } }
            }
            if (j <= 0) {
                for (int p = 0; p < 64; ++p) { const f32x2 cv = Cph[(64 + p) * 16 + h], w = pw[(64 + p) * 66 - j]; const float cwr = cv.x * w.x - cv.y * w.y, cwi = cv.x * w.y + cv.y * w.x;
#pragma unroll
                    for (int k = 0; k < 16; ++k) { const f32x2 b = Bb[(64 + p) * 16 + k]; a[k] += cwr * b.x - cwi * b.y; } }
            }
            if (j == 0) { const float dv = P.s5d[g * 16 + h];
#pragma unroll
                for (int k = 0; k < 16; ++k) a[k] += (k == h) ? dv : 0.f; }
            u32x4 w0, w1; w0.x = pk2(a[0], a[1]); w0.y = pk2(a[2], a[3]); w0.z = pk2(a[4], a[5]); w0.w = pk2(a[6], a[7]); w1.x = pk2(a[8], a[9]); w1.y = pk2(a[10], a[11]); w1.z = pk2(a[12], a[13]); w1.w = pk2(a[14], a[15]);
            u32x4* dst = (u32x4*)(Kc + ((size_t)jj * 16 + h) * 16); dst[0] = w0; dst[1] = w1;
        }
    } else if (part == 2) {
        bf16_t* Wc = (bf16_t*)((unsigned char*)P.out + OUT_WC) + (size_t)g * 1024 * 256;
        const int w = tid >> 6, p = tid & 63;
        for (int it = w; it < 2048; it += 8) {
            const int dir = it & 1, h = (it >> 1) & 15, tl = it >> 5, e = dir ? 64 - tl : tl + 1;
            const f32x2 cv = Chp[(dir * 16 + h) * 64 + p], a = pw[(dir * 64 + p) * 66 + e];
            const float zr = cv.x * a.x - cv.y * a.y, zi = cv.x * a.y + cv.y * a.x;
            bf16_t* d = Wc + (size_t)(tl * 16 + h) * 256 + dir * 128 + p;
            d[0] = (bf16_t)f2bf(zr); d[64] = (bf16_t)f2bf(-zi);
        }
    } else {
        bf16_t* We = (bf16_t*)((unsigned char*)P.out + OUT_WEND) + (size_t)g * 256 * 1024;
        const int s = tid >> 3, h0 = (tid & 7) * 2;
        for (int it = 0; it < 128; ++it) {
            const int dir = it >> 6, p = it & 63, e = dir ? s : 63 - s;
            const f32x2 a = pw[(dir * 64 + p) * 66 + e], b0 = Bb[(dir * 64 + p) * 16 + h0], b1 = Bb[(dir * 64 + p) * 16 + h0 + 1];
            const float z0r = a.x * b0.x - a.y * b0.y, z0i = a.x * b0.y + a.y * b0.x, z1r = a.x * b1.x - a.y * b1.y, z1i = a.x * b1.y + a.y * b1.x;
            bf16_t* d = We + (size_t)(dir * 128 + p) * 1024 + s * 16 + h0;
            *(unsigned*)d = pk2(z0r, z1r); *(unsigned*)(d + 64 * 1024) = pk2(z0i, z1i);
        }
    }
    __syncthreads();
}

#define XB_TMO      128
#define XB_XCNT(j)  (256  + 64 * (j))
#define XB_XSUB(j)  (1280 + 64 * (j))
#define XB_XGEN(j)  (2304 + 64 * (j))
#define XB_TOP      3328
#define XB_TOPGEN   3392
#define XCD_BAR_WORDS 3456
#define XB_SPIN_CAP (1u << 22)
__device__ __forceinline__ unsigned xb_ld(unsigned* p)              { return __hip_atomic_load(p, __ATOMIC_RELAXED, __HIP_MEMORY_SCOPE_AGENT); }
__device__ __forceinline__ unsigned xb_add(unsigned* p, unsigned v) { return __hip_atomic_fetch_add(p, v, __ATOMIC_RELAXED, __HIP_MEMORY_SCOPE_AGENT); }
__device__ __forceinline__ unsigned xb_xcc_id() { return (unsigned)__builtin_amdgcn_s_getreg((3 << 11) | 20) & 0xFu; }
#define XB_SPIN(cond, bar) do { unsigned _sp = 0; while (cond) { __builtin_amdgcn_s_sleep(1); \
    if ((++_sp & 255u) == 0u) { if (xb_ld(&(bar)[XB_TMO])) break; if (_sp > XB_SPIN_CAP) { atomicAdd(&(bar)[XB_TMO], 1u); break; } } } } while (0)
__device__ __forceinline__ void xcd_barrier_complete(unsigned* bar, unsigned x, unsigned& nloc, unsigned& nx) {
    const unsigned G = gridDim.x * gridDim.y * gridDim.z;
    unsigned sum, cnt, mine, sp = 0u;
    for (;;) {
        sum = 0u; cnt = 0u; mine = 0u;
#pragma unroll
        for (unsigned j = 0; j < 16; ++j) { const unsigned c = xb_ld(&bar[XB_XCNT(j)]); sum += c; cnt += (c > 0u) ? 1u : 0u; mine = (j == x) ? c : mine; }
        if (sum == G) break;
        __builtin_amdgcn_s_sleep(1);
        if ((++sp & 255u) == 0u) { if (xb_ld(&bar[XB_TMO])) break; if (sp > XB_SPIN_CAP) { atomicAdd(&bar[XB_TMO], 1u); break; } }
    }
    nloc = mine > 0u ? mine : 1u; nx = cnt > 0u ? cnt : 1u;
}
__device__ __forceinline__ void xcd_barrier(unsigned* bar, volatile LAS unsigned* st) {
    asm volatile("s_waitcnt vmcnt(0)" ::: "memory");
    __syncthreads();
    if (threadIdx.x == 0) {
        __builtin_amdgcn_s_waitcnt(0);
        const unsigned x = xb_xcc_id();
        unsigned nloc = st[0], nx = st[1];
        if (nloc == 0u) {
            xcd_barrier_complete(bar, x, nloc, nx); st[0] = nloc; st[1] = nx;
            unsigned rank = st[2];
            for (unsigned j = 0; j < 16; ++j) if (j < x) rank += xb_ld(&bar[XB_XCNT(j)]);
            const unsigned G = gridDim.x, per = (G + nx - 1) / nx;
            st[3] = (G % 8 == 0 && nx == 8) ? (rank % per) * 8 + rank / per : rank;
        }
        const unsigned old = xb_add(&bar[XB_XSUB(x)], 1u);
        const unsigned gen = old / nloc;
        if (old + 1u == (gen + 1u) * nloc) {
            __builtin_amdgcn_fence(__ATOMIC_RELEASE, "agent");
            asm volatile("s_waitcnt vmcnt(0)" ::: "memory");
            const unsigned og = xb_add(&bar[XB_TOP], 1u);
            const unsigned tg = og / nx;
            if (og + 1u == (tg + 1u) * nx) xb_add(&bar[XB_TOPGEN], 1u);
            else XB_SPIN(xb_ld(&bar[XB_TOPGEN]) == tg, bar);
            __builtin_amdgcn_fence(__ATOMIC_ACQUIRE, "agent");
            xb_add(&bar[XB_XGEN(x)], 1u);
            asm volatile("s_waitcnt vmcnt(0)" ::: "memory");
        } else {
            XB_SPIN(xb_ld(&bar[XB_XGEN(x)]) == gen, bar);
            __builtin_amdgcn_fence(__ATOMIC_ACQUIRE, "agent");
            asm volatile("s_waitcnt vmcnt(0)" ::: "memory");
        }
    }
    __syncthreads();
}

__global__ void __launch_bounds__(512, 2) fwd_megakernel(Params Pk) {
    extern __shared__ __attribute__((aligned(16))) unsigned char lds_raw[];
    LAS unsigned char* lds = (LAS unsigned char*)lds_raw;
    cg::grid_group grid = cg::this_grid();
    const int G = gridDim.x;
    const int lo = Pk.ph_lo, hi = Pk.ph_hi;
    volatile LAS unsigned* misc = (volatile LAS unsigned*)(lds + LDS_MISC);
    unsigned* barw = (unsigned*)(Pk.ws + OFF_BAR);
    if (threadIdx.x < 4) misc[threadIdx.x] = (threadIdx.x == 3) ? blockIdx.x : 0u;
    __syncthreads();
    if (ONE_LAUNCH && threadIdx.x == 0) misc[2] = xb_add(&barw[XB_XCNT(xb_xcc_id())], 1u);
    if (hi == 12345) grid.sync();
#if defined(__HIP_DEVICE_COMPILE__)
#define LOAD_PARAMS const __attribute__((address_space(4))) Params* _pp = (const __attribute__((address_space(4))) Params*)__builtin_amdgcn_kernarg_segment_ptr(); asm volatile("" : "+s"(_pp)); const Params P = *_pp;
#else
#define LOAD_PARAMS const Params P = Pk;
#endif
#define PHASE_VARS \
    LOAD_PARAMS \
    const int tid = opaque_tid(), lane = tid & 63, wid = tid >> 6, bx = (int)misc[3], gw = bx * 8 + wid, NW = G * 8; (void)lane; (void)gw; (void)NW; \
    unsigned char* ws = P.ws; bf16_t* xb = (bf16_t*)(ws + OFF_XB); bf16_t* Hb = (bf16_t*)(ws + OFF_H); float* rowss = (float*)(ws + OFF_ROWSS); float* x = P.out; \
    const float* xin_hi = P.xin1 - (size_t)TP * D; (void)xb; (void)Hb; (void)rowss; (void)x; (void)xin_hi;
#define PHASE(k) if (lo <= (k) && (k) < hi) for (int rep = 0; rep < nrep(k); ++rep)
#define LASTREP(k) (rep + 1 >= nrep(k))
#define SEAM(k) do { if (!LASTREP(k) || (k) + 1 < hi) xcd_barrier((unsigned*)(P.ws + OFF_BAR), misc); if (PROBE & 16) xcd_barrier((unsigned*)(P.ws + OFF_BAR), misc); } while (0)

    PHASE(0) { PHASE_VARS
        if (bx & 1) for (int it = bx; it < NG * 4; it += G) s5_tables(P, it >> 2, it & 3, lds_raw);
        for (int row = gw; row < T; row += 4 * NW) {
            f32x4 v[4][4];
#pragma unroll
            for (int r = 0; r < 4; ++r) { const int rr = (row + r * NW) < T ? (row + r * NW) : row; const float* src = (rr < TP ? P.xin0 : xin_hi) + (size_t)rr * D;
#pragma unroll
                for (int k = 0; k < 4; ++k) v[r][k] = *(const f32x4*)(src + k * 256 + lane * 4); }
#pragma unroll
            for (int r = 0; r < 4; ++r) { const int rr = (row + r * NW) < T ? (row + r * NW) : row; float ss = 0.f;
#pragma unroll
                for (int k = 0; k < 4; ++k) { const f32x4 q = v[r][k]; ss += (q[0] * q[0] + q[1] * q[1]) + (q[2] * q[2] + q[3] * q[3]);
                    u32x2 w; w.x = pk2(q[0], q[1]); w.y = pk2(q[2], q[3]); *(u32x2*)(xb + (size_t)rr * D + k * 256 + lane * 4) = w; }
                ss = wave_sum(ss);
                if (lane < 4) rowss[(size_t)rr * 32 + lane] = lane == 0 ? ss : 0.f; }
        }
        {
            conv_block<6>(job_gu(P, 0, 0), NWI_GU, gw, NW, lane);
            for (int w2 = gw; w2 < NWI_POOL; w2 += NW) {
                const int rb = w2 >> 5, k0 = (w2 & 31) * 8, g = rb >> 2, d0 = (rb & 3) * 64;
                const float* src = P.pool_w + (size_t)g * 65536 + (size_t)k0 * 256 + d0 + lane; bf16_t* dst = (bf16_t*)(ws + OFF_WPOOL) + (size_t)(rb * 64 + lane) * 256 + k0;
                float v[8]; conv_load(src, 256, v); conv_store(dst, v, nullptr, P.pool_scale[g * 256 + d0 + lane]);
            }
            for (int w2 = gw; w2 < NWI_GLU; w2 += NW) {
                const int rb = w2 >> 7, k0 = (w2 & 127) * 8, pn = rb >> 2, bj = (rb >> 1) & 1;
                const float* src = P.glu_a + (ptrdiff_t)bj * (P.glu_b - P.glu_a) + (size_t)k0 * D + pn * 128 + (rb & 1) * 64 + lane; bf16_t* dst = (bf16_t*)(ws + OFF_WGLU) + (size_t)(rb * 64 + lane) * D + k0;
                float v[8]; conv_load(src, D, v); conv_store(dst, v, nullptr, 1.0f);
            }
        }
        if (!(bx & 1)) for (int it = bx; it < NG * 4; it += G) s5_tables(P, it >> 2, it & 3, lds_raw);
        SEAM(0);
    }
#define PH_GU(k, nq_, cjob) PHASE(k) { PHASE_VARS GemmGU g; g.cj = job_none(); if (LASTREP(k) && (bx & 1)) conv_block<3>((cjob), NWI_DN, gw, NW, lane); g.A = (const char*)xb; g.B = (const char*)(ws + OFF_WGU); g.H = Hb; g.rs_lds = (const LAS float*)(lds + LDS_RS); g.nq = (nq_); g.dry = !LASTREP(k); \
        { const int pmr = 16 * (bx & 7) + ((bx >> 3) & 7) + 8 * (tid >> 8); ((LAS float*)(lds + LDS_RS))[tid] = row_rstd(rowss, pmr * 256 + (tid & 255), (nq_)); __syncthreads(); } \
        if ((PROBE & 1024) && g.dry && (bx & 8)) { } else if ((PROBE & 768) && g.dry) gemm_phase<GemmGU, (PROBE >> 8) & 3>(lds, g, G, bx); else gemm_phase(lds, g, G, bx); if (LASTREP(k) && !(bx & 1)) conv_block<3>((cjob), NWI_DN, gw, NW, lane); SEAM(k); }
#define PH_DN(k, cjob) PHASE(k) { PHASE_VARS GemmResid<FF, FF, 44> g; g.cj = job_none(); if (LASTREP(k) && (bx & 1)) conv_block<6>((cjob), NWI_GU, gw, NW, lane); g.A = (const char*)Hb; g.B = (const char*)(ws + OFF_WD); g.xb = xb; g.rowss = rowss; g.coef = LASTREP(k) ? 0.5f : 0.f; g.pool = 0; gemm_phase(lds, g, G, bx); if (LASTREP(k) && !(bx & 1)) conv_block<6>((cjob), NWI_GU, gw, NW, lane); SEAM(k); }
    PH_GU(1, 1, job_dn(P, 0, 0))
    PH_DN(2, job_gu(P, 0, 1))
    PHASE(3) { PHASE_VARS
        bf16_t* Ug = (bf16_t*)P.out; const float* g1 = P.norm_g + 1 * D;
        f32x4 gv[4];
#pragma unroll
        for (int k = 0; k < 4; ++k) gv[k] = *(const f32x4*)(g1 + lane * 16 + k * 4);
        for (int base = gw * 4; base < T; base += NW * 4) {
            u32x4 q[4][2];
#pragma unroll
            for (int r = 0; r < 4; ++r) { const u32x4* src = (const u32x4*)(xb + (size_t)(base + r) * D + lane * 16); q[r][0] = src[0]; q[r][1] = src[1]; }
#pragma unroll
            for (int r = 0; r < 4; ++r) { const int row = base + r; const u32x4 q0 = q[r][0], q1 = q[r][1]; float v[16];
                v[0] = bf_lo(q0.x); v[1] = bf_hi(q0.x); v[2] = bf_lo(q0.y); v[3] = bf_hi(q0.y); v[4] = bf_lo(q0.z); v[5] = bf_hi(q0.z); v[6] = bf_lo(q0.w); v[7] = bf_hi(q0.w);
                v[8] = bf_lo(q1.x); v[9] = bf_hi(q1.x); v[10] = bf_lo(q1.y); v[11] = bf_hi(q1.y); v[12] = bf_lo(q1.z); v[13] = bf_hi(q1.z); v[14] = bf_lo(q1.w); v[15] = bf_hi(q1.w);
                float ss = 0.f;
#pragma unroll
                for (int k = 0; k < 16; ++k) ss += v[k] * v[k];
                ss = wave_sum(ss); const float rs = __builtin_amdgcn_rsqf(ss * (1.0f / 1024.0f) + EPS);
#pragma unroll
                for (int k = 0; k < 16; ++k) v[k] *= rs * gv[k >> 2][k & 3];
                u32x4 w0, w1;
                w0.x = pk2(v[0], v[1]); w0.y = pk2(v[2], v[3]); w0.z = pk2(v[4], v[5]); w0.w = pk2(v[6], v[7]);
                w1.x = pk2(v[8], v[9]); w1.y = pk2(v[10], v[11]); w1.z = pk2(v[12], v[13]); w1.w = pk2(v[14], v[15]);
                u32x4* dst = (u32x4*)(Ug + ((size_t)lane * NCH + (row >> 6)) * D + (row & 63) * 16); dst[0] = w0; dst[1] = w1; }
        }
        SEAM(3);
    }
    PHASE(4) { PHASE_VARS GemmSend g; g.A = (const char*)P.out; g.B = (const char*)P.out + OUT_WEND; g.Send = (float*)(ws + OFF_SEND); gemm_phase(lds, g, G, bx); SEAM(4); }
    PHASE(5) { PHASE_VARS
        const float* Send = (const float*)(ws + OFF_SEND); bf16_t* Sin = (bf16_t*)(ws + OFF_SIN); const f32x2* aL = (const f32x2*)(ws + OFF_AL); f32x2* endst = (f32x2*)lds_raw;
        constexpr size_t HALF2 = (size_t)NG * NCH * 256;
        for (int task = bx; task < NG * 4; task += G) {
            const int g = task >> 2, dir = (task >> 1) & 1, kind = task & 1;
            const f32x2 a = aL[(g * 2 + dir) * 64 + lane];
            const float* E = Send + (size_t)g * NCH * 256 + dir * 128 + lane; bf16_t* S = Sin + (size_t)g * NCH * 256 + dir * 128 + lane;
            const int cfirst = kind ? (dir ? 256 + 32 * wid + 31 : 256 + 32 * wid) : (dir ? 255 - 32 * wid : 32 * wid), cstep = dir ? -1 : 1;
            float sr = 0.f, si = 0.f;
            if (kind == 0) {
#pragma unroll 8
                for (int i = 0; i < 32; ++i) { const size_t o = (size_t)(cfirst + cstep * i) * 256;
                    const float er = E[o] + E[o + HALF2], ei = E[o + 64] + E[o + 64 + HALF2];
                    const float nr = a.x * sr - a.y * si + er, ni = a.x * si + a.y * sr + ei; sr = nr; si = ni; }
                endst[wid * 64 + lane] = (f32x2){sr, si};
            }
            __syncthreads();
            sr = 0.f; si = 0.f;
            if (kind == 0) {
                f32x2 as = a;
#pragma unroll
                for (int q = 0; q < 5; ++q) as = (f32x2){as.x * as.x - as.y * as.y, 2.f * as.x * as.y};
                for (int r = 0; r < wid; ++r) { const f32x2 e = endst[r * 64 + lane]; const float nr = as.x * sr - as.y * si + e.x, ni = as.x * si + as.y * sr + e.y; sr = nr; si = ni; }
            }
#pragma unroll 8
            for (int i = 0; i < 32; ++i) { const size_t o = (size_t)(cfirst + cstep * i) * 256;
                const float er = E[o] + E[o + HALF2], ei = E[o + 64] + E[o + 64 + HALF2];
                S[o] = (bf16_t)f2bf(sr); S[o + 64] = (bf16_t)f2bf(si);
                const float nr = a.x * sr - a.y * si + er, ni = a.x * si + a.y * sr + ei; sr = nr; si = ni; }
            __syncthreads();
        }
        SEAM(5);
    }
    PHASE(6) { PHASE_VARS GemmToep g; g.Ug = (const char*)P.out; g.Sin = (const char*)(ws + OFF_SIN); g.Kc = (const char*)(ws + OFF_KC); g.Wc = (const char*)P.out + OUT_WC; g.gact = (bf16_t*)(ws + OFF_GACT); gemm_phase(lds, g, G, bx); SEAM(6); }
    PHASE(7) { PHASE_VARS GemmGLU g; g.A = (const char*)(ws + OFF_GACT); g.B = (const char*)(ws + OFF_WGLU); g.xb = xb; g.rowss = rowss; g.coef = LASTREP(7) ? 1.0f : 0.f; gemm_phase(lds, g, G, bx); SEAM(7); }
    PH_GU(8, 8, job_dn(P, 0, 1))
    PH_DN(9, job_gu(P, 1, 0))
    PH_GU(11, 4, job_dn(P, 1, 0))
    PH_DN(12, job_gu(P, 1, 1))
    PHASE(13) { PHASE_VARS
        bf16_t* pbuf = (bf16_t*)(ws + OFF_PBUF); const float* g1 = P.norm_g + (3 + 1) * D; float* rs = (float*)lds_raw;
        for (int ch = bx; ch < NCH; ch += G) {
            const int t0 = ch * 64; const int sbeg = t0 < TP ? 0 : TP + ((t0 - TP) / DSEQ) * DSEQ, send = t0 < TP ? TP : sbeg + DSEQ;
            if (tid < 80) { const int tok = t0 - 8 + tid; rs[tid] = (tok >= sbeg && tok < send) ? row_rstd(rowss, tok, 4) : 0.f; }
            __syncthreads();
            const int cq = tid & 255, half = tid >> 8, hw = 1 << (cq >> 6), ta = t0 + 32 * half;
            const f32x4 gv = *(const f32x4*)(g1 + cq * 4);
            f32x4 S = (f32x4){0.f, 0.f, 0.f, 0.f};
#define LDX(tok) ({ const u32x2 _q = *(const u32x2*)(xb + (size_t)(tok) * D + cq * 4); (f32x4){bf_lo(_q.x), bf_hi(_q.x), bf_lo(_q.y), bf_hi(_q.y)} * rs[(tok) - t0 + 8]; })
            for (int s = ta - hw; s <= ta + hw - 2; ++s) if (s >= sbeg && s < send) S += LDX(s);
            for (int t = ta; t < ta + 32; ++t) {
                const int sin_ = t + hw - 1; if (sin_ < send) S += LDX(sin_);
                const int wl = (t - hw) > sbeg ? (t - hw) : sbeg, wh = (t + hw) < send ? (t + hw) : send; const float inv = 1.0f / (float)(wh - wl);
                const f32x4 xt = LDX(t);
                const f32x4 pv = (S * inv - xt) * gv;
                u32x2 w; w.x = pk2(pv[0], pv[1]); w.y = pk2(pv[2], pv[3]); *(u32x2*)(pbuf + (size_t)t * D + cq * 4) = w;
                const int sout = t - hw; if (sout >= sbeg) S -= LDX(sout);
            }
#undef LDX
            __syncthreads();
        }
        SEAM(13);
    }
    PHASE(14) { PHASE_VARS GemmResid<D, 256, 4> g; g.cj = job_none(); g.A = (const char*)(ws + OFF_PBUF); g.B = (const char*)(ws + OFF_WPOOL); g.xb = xb; g.rowss = rowss; g.coef = LASTREP(14) ? 1.0f : 0.f; g.pool = 1; gemm_phase(lds, g, G, bx); SEAM(14); }
    PH_GU(15, 4, job_dn(P, 1, 1))
    PH_DN(16, job_none())
    PHASE(17) { PHASE_VARS
        f32x4 gv[4];
#pragma unroll
        for (int k = 0; k < 4; ++k) gv[k] = *(const f32x4*)(P.final_g + (k >> 1) * 512 + lane * 8 + (k & 1) * 4);
        for (int row = gw; row < T; row += 4 * NW) {
            u32x4 q[4][2];
#pragma unroll
            for (int r = 0; r < 4; ++r) { const int rr = (row + r * NW) < T ? (row + r * NW) : row;
#pragma unroll
                for (int k = 0; k < 2; ++k) q[r][k] = *(const u32x4*)(xb + (size_t)rr * D + k * 512 + lane * 8); }
#pragma unroll
            for (int r = 0; r < 4; ++r) { const int rr = (row + r * NW) < T ? (row + r * NW) : row; float* dst = x + (size_t)rr * D; f32x4 v[4]; float ss = 0.f;
#pragma unroll
                for (int k = 0; k < 2; ++k) { const u32x4 w = q[r][k];
                    v[2 * k] = (f32x4){bf_lo(w.x), bf_hi(w.x), bf_lo(w.y), bf_hi(w.y)}; v[2 * k + 1] = (f32x4){bf_lo(w.z), bf_hi(w.z), bf_lo(w.w), bf_hi(w.w)}; }
#pragma unroll
                for (int k = 0; k < 4; ++k) ss += (v[k][0] * v[k][0] + v[k][1] * v[k][1]) + (v[k][2] * v[k][2] + v[k][3] * v[k][3]);
                ss = wave_sum(ss); const float rs = __builtin_amdgcn_rsqf(ss * (1.0f / 1024.0f) + EPS);
#pragma unroll
                for (int k = 0; k < 4; ++k) *(f32x4*)(dst + (k >> 1) * 512 + lane * 8 + (k & 1) * 4) = v[k] * rs * gv[k]; }
        }
    }
#undef PHASE
#undef SEAM
}

extern "C" void kernel_launch(void* const* d_in, const int* in_sizes, int n_in, void* d_out, int out_size, void* d_ws, size_t ws_size, hipStream_t stream) {
    static int grid = 0;
    if (grid == 0) {
        int dev = 0, cus = 0, per_cu = 0;
        (void)hipGetDevice(&dev); (void)hipDeviceGetAttribute(&cus, hipDeviceAttributeMultiprocessorCount, dev);
        if (hipFuncSetAttribute((const void*)fwd_megakernel, hipFuncAttributeMaxDynamicSharedMemorySize, LDS_BYTES) != hipSuccess) fprintf(stderr, "kernel_launch: hipFuncSetAttribute failed\n");
        if (hipOccupancyMaxActiveBlocksPerMultiprocessor(&per_cu, (const void*)fwd_megakernel, 512, LDS_BYTES) != hipSuccess || per_cu < 1) { fprintf(stderr, "kernel_launch: occupancy query says %d\n", per_cu); per_cu = 1; }
        (void)hipGetLastError();
        grid = cus > 0 ? cus : 256;
        if (ws_size < WS_END) fprintf(stderr, "kernel_launch: workspace too small: %zu < %zu\n", ws_size, (size_t)WS_END);
    }
    Params p{};
    p.xin0 = (const float*)d_in[0]; p.xin1 = (const float*)d_in[1]; p.norm_g = (const float*)d_in[2]; p.final_g = (const float*)d_in[3];
    p.wg = (const float*)d_in[4]; p.wu = (const float*)d_in[5]; p.wd = (const float*)d_in[6];
    p.lam_re = (const float*)d_in[7]; p.lam_im = (const float*)d_in[8]; p.log_step = (const float*)d_in[9];
    p.b_re = (const float*)d_in[10]; p.b_im = (const float*)d_in[11]; p.c_re = (const float*)d_in[12]; p.c_im = (const float*)d_in[13];
    p.s5d = (const float*)d_in[14]; p.glu_a = (const float*)d_in[15]; p.glu_b = (const float*)d_in[16]; p.pool_w = (const float*)d_in[17]; p.pool_scale = (const float*)d_in[18];
    p.out = (float*)d_out; p.ws = (unsigned char*)d_ws;
#if ONE_LAUNCH
    (void)hipMemsetAsync((char*)d_ws + OFF_BAR, 0, XCD_BAR_WORDS * 4, stream);
    p.ph_lo = 0; p.ph_hi = NPHASE;
    void* args[] = {&p};
    hipError_t e = hipLaunchCooperativeKernel((const void*)fwd_megakernel, dim3(grid), dim3(512), args, LDS_BYTES, stream);
    if (e != hipSuccess) fprintf(stderr, "cooperative launch failed: %s (grid %d)\n", hipGetErrorString(e), grid);
#else
    for (int k = 0; k < NPHASE; ++k) { p.ph_lo = k; p.ph_hi = k + 1; hipLaunchKernelGGL(fwd_megakernel, dim3(grid), dim3(512), LDS_BYTES, stream, p); }
#endif
}
```

```cpp
#include <hip/hip_runtime.h>
#include <hip/hip_cooperative_groups.h>
#include <cstdio>
#include <cstddef>
namespace cg = cooperative_groups;

#define LAS __attribute__((address_space(3)))
typedef unsigned short bf16_t;
typedef short bf16x8 __attribute__((ext_vector_type(8)));
typedef float f32x4 __attribute__((ext_vector_type(4)));
typedef float f32x2 __attribute__((ext_vector_type(2)));
typedef unsigned u32x4 __attribute__((ext_vector_type(4)));
typedef unsigned u32x2 __attribute__((ext_vector_type(2)));

#ifndef ONE_LAUNCH
#define ONE_LAUNCH 1
#endif

constexpr int T = 32768, TP = 16384, D = 1024, FF = 2816, NGU = 5632, DSEQ = 2048;
constexpr int LC = 64, NCH = 512, NG = 64;
constexpr float EPS = 1e-6f;
constexpr size_t MiB = 1u << 20;
constexpr size_t OFF_XB = 0, OFF_H = 64 * MiB;
constexpr size_t OFF_SIN = OFF_H, OFF_KC = 266 * MiB, OUT_WC = 64 * MiB, OUT_WEND = 96 * MiB  , OFF_SEND = OFF_H + 84 * MiB, OFF_GACT = OFF_H + 52 * MiB, OFF_PBUF = OFF_H;
constexpr size_t OFF_WGU = 240 * MiB, OFF_WD = 251 * MiB, OFF_WGLU = 256 * MiB + MiB / 2, OFF_WPOOL = 260 * MiB + MiB / 2, OFF_ROWSS = 261 * MiB, OFF_AL = 265 * MiB, OFF_BAR = 265 * MiB + 65536, WS_END = 270 * MiB;
constexpr int LDS_BYTES = 131072 + 2048 + 16, LDS_RS = 131072, LDS_MISC = 131072 + 2048;
constexpr int NPHASE = 18;
#ifndef PROBE
#define PROBE 0
#endif
__host__ __device__ constexpr int nrep(int k) {
    return ((PROBE & 33) && (k == 1 || k == 8 || k == 11 || k == 15)) || ((PROBE & 66) && (k == 2 || k == 9 || k == 12 || k == 16)) || ((PROBE & 4) && (k == 0 || k == 3 || k == 10 || k == 13))
        || ((PROBE & 8) && (k == 4 || k == 5 || k == 6 || k == 7 || k == 14)) ? 2 : 1;
}

struct Params {
    const float* xin0; const float* xin1; const float* norm_g; const float* final_g;
    const float* wg; const float* wu; const float* wd;
    const float* lam_re; const float* lam_im; const float* log_step; const float* b_re; const float* b_im; const float* c_re; const float* c_im;
    const float* s5d; const float* glu_a; const float* glu_b; const float* pool_w; const float* pool_scale;
    float* out; unsigned char* ws; int ph_lo, ph_hi;
};

__device__ __forceinline__ unsigned f2bf(float f) { unsigned u = __builtin_bit_cast(unsigned, f); return (u + 0x7fffu + ((u >> 16) & 1u)) >> 16; }
#if defined(__HIP_DEVICE_COMPILE__)
__device__ __forceinline__ unsigned pk2(float lo, float hi) { unsigned r; asm volatile("v_cvt_pk_bf16_f32 %0, %1, %2" : "=v"(r) : "v"(lo), "v"(hi)); return r; }
#else
__device__ __forceinline__ unsigned pk2(float lo, float hi) { return f2bf(lo) | (f2bf(hi) << 16); }
#endif
__device__ __forceinline__ float fast_sigmoid(float z) { return __builtin_amdgcn_rcpf(1.0f + __expf(-z)); }
__device__ __forceinline__ float wave_sum(float s) {
#pragma unroll
    for (int o = 32; o >= 1; o >>= 1) s += __shfl_xor(s, o);
    return s;
}
__device__ __forceinline__ float row_rstd(const float* rowss, int row, int nq) {
    const f32x4* p = (const f32x4*)(rowss + (size_t)row * 32); float s = 0.f;
    for (int k = 0; k < nq; ++k) { const f32x4 v = p[k]; s += (v[0] + v[1]) + (v[2] + v[3]); }
    return __builtin_amdgcn_rsqf(s * (1.0f / 1024.0f) + EPS);
}

__device__ __forceinline__ int lds_byte(int r, int c) { const int st = (r >> 4) * 2 + (c >> 5), rr = r & 15, cc = c & 31, ob = rr * 64 + cc * 2; return st * 1024 + (ob ^ (((ob >> 9) & 1) << 5)); }
__device__ __forceinline__ void stage_rc(int b, int& R, int& C) { const int st = b / 1024, sb = b % 1024, swz = sb ^ (((sb >> 9) & 1) << 5); R = (st >> 1) * 16 + swz / 64; C = (st & 1) * 32 + (swz % 64) / 2; }
__device__ __forceinline__ int perm32(int rho) { const int n = rho >> 4, i = rho & 15; return 8 * (i >> 2) + 4 * n + (i & 3); }

struct Unit { int pm, pn, g; };
__device__ __forceinline__ int opaque_tid() { int t = threadIdx.x; asm volatile("" : "+v"(t)); return t; }

__device__ __forceinline__ bool order_mn(int L, int nM, int nN, int& pm, int& pn) {
    const int nwg = nM * nN; if (L >= nwg) return false;
    int wgid = L; { const int q = nwg / 8, r = nwg % 8, xcd = wgid % 8, off = wgid / 8; wgid = (xcd < r ? xcd * (q + 1) : r * (q + 1) + (xcd - r) * q) + off; }
    const int nig = 8 * nN, gid = wgid / nig, fm = gid * 8, gsz = (nM - fm) < 8 ? (nM - fm) : 8;
    pm = fm + ((wgid % nig) % gsz); pn = (wgid % nig) / gsz; return true;
}

constexpr int HTB = 128 * 64 * 2;

__device__ __forceinline__ void stage2(LAS unsigned char* dst, const char* g, int v0, int v1) {
    __builtin_amdgcn_global_load_lds((const unsigned*)(g + v0), (LAS unsigned*)dst, 16, 0, 0);
    __builtin_amdgcn_global_load_lds((const unsigned*)(g + v1), (LAS unsigned*)(dst + 8192), 16, 0, 0);
}

template <class P, int MODE = 0>
__device__ __forceinline__ void gemm_phase(LAS unsigned char* lds, const P& p, int G, int c) {
    const int tid = opaque_tid(), wid = __builtin_amdgcn_readfirstlane(tid >> 6), lane = tid & 63, wr = wid >> 2, wc = wid & 3, fr = lane & 15, fq = lane >> 4;
    constexpr int nt = P::NT;
    int voA0, voA1, voB0, voB1, voA20 = 0, voA21 = 0, voB20 = 0, voB21 = 0;
    { int R, C; stage_rc(tid * 16, R, C); int Rb = P::PERM ? ((R & ~31) + perm32(R & 31)) : R; voA0 = p.voffA(R, C); voB0 = p.voffB(Rb, C);
      if constexpr (P::SEG) { voA20 = p.voffA2(R, C); voB20 = p.voffB2(Rb, C); } }
    { int R, C; stage_rc(tid * 16 + 8192, R, C); int Rb = P::PERM ? ((R & ~31) + perm32(R & 31)) : R; voA1 = p.voffA(R, C); voB1 = p.voffB(Rb, C);
      if constexpr (P::SEG) { voA21 = p.voffA2(R, C); voB21 = p.voffB2(Rb, C); } }
    const ptrdiff_t kA = p.kA(), hA = p.hA(), kB = p.kB(), hB = p.hB();
    const ptrdiff_t kA2 = P::SEG ? p.kA2() : 0, hA2 = P::SEG ? p.hA2() : 0, kB2 = P::SEG ? p.kB2() : 0, hB2 = P::SEG ? p.hB2() : 0;
    const unsigned ldsw = (unsigned)wid * 1024u;
    const int aoff = lds_byte(wr * 64 + fr, fq * 8), boff = lds_byte(wc * 32 + fr, fq * 8);
#define G_SA(b, h) (((b) * 2 + (h)) * HTB)
#define G_SB(b, h) ((4 + (b) * 2 + (h)) * HTB)
#define G_STAGE_A(buf, h, b0, b1, tt) do { const bool _s2 = P::SEG && (tt) >= P::TS; \
        const char* _g = _s2 ? (b1) + (ptrdiff_t)((tt) - P::TS) * kA2 + (ptrdiff_t)(h) * hA2 : (b0) + (ptrdiff_t)(tt) * kA + (ptrdiff_t)(h) * hA; \
        stage2(lds + G_SA(buf, h) + ldsw, _g, _s2 ? voA20 : voA0, _s2 ? voA21 : voA1); } while (0)
#define G_STAGE_B(buf, h, b0, b1, tt) do { const bool _s2 = P::SEG && (tt) >= P::TS; \
        const char* _g = _s2 ? (b1) + (ptrdiff_t)((tt) - P::TS) * kB2 + (ptrdiff_t)(h) * hB2 : (b0) + (ptrdiff_t)(tt) * kB + (ptrdiff_t)(h) * hB; \
        stage2(lds + G_SB(buf, h) + ldsw, _g, _s2 ? voB20 : voB0, _s2 ? voB21 : voB1); } while (0)
#define G_LDA(dst, b, h) do { if (MODE != 2) { _Pragma("unroll") for (int m = 0; m < 4; ++m) _Pragma("unroll") for (int k = 0; k < 2; ++k) dst[m][k] = *(const LAS bf16x8*)(lds + G_SA(b, h) + aoff + m * 2048 + k * 1024); } } while (0)
#define G_LDB(dst, b, h) do { if (MODE != 2) { _Pragma("unroll") for (int n = 0; n < 2; ++n) _Pragma("unroll") for (int k = 0; k < 2; ++k) dst[n][k] = *(const LAS bf16x8*)(lds + G_SB(b, h) + boff + n * 2048 + k * 1024); } } while (0)
#define G_MMA(ai, bj, At, Bt, Z) do { if (MODE == 1) { _Pragma("unroll") for (int m = 0; m < 4; ++m) _Pragma("unroll") for (int k = 0; k < 2; ++k) asm volatile("" :: "v"(At[m][k])); \
            _Pragma("unroll") for (int n = 0; n < 2; ++n) _Pragma("unroll") for (int k = 0; k < 2; ++k) asm volatile("" :: "v"(Bt[n][k])); } else { \
        __builtin_amdgcn_s_setprio(1); \
        _Pragma("unroll") for (int m = 0; m < 4; ++m) _Pragma("unroll") for (int n = 0; n < 2; ++n) \
            acc[ai][bj][m][n] = __builtin_amdgcn_mfma_f32_16x16x32_bf16(Bt[n][0], At[m][0], (Z) ? (f32x4){0.f, 0.f, 0.f, 0.f} : acc[ai][bj][m][n], 0, 0, 0); \
        _Pragma("unroll") for (int m = 0; m < 4; ++m) _Pragma("unroll") for (int n = 0; n < 2; ++n) \
            acc[ai][bj][m][n] = __builtin_amdgcn_mfma_f32_16x16x32_bf16(Bt[n][1], At[m][1], acc[ai][bj][m][n], 0, 0, 0); \
        __builtin_amdgcn_s_setprio(0); } } while (0)
#define G_WAIT_V(n) asm volatile("s_waitcnt vmcnt(" #n ")" ::: "memory")
#define G_WAIT_L(n) asm volatile("s_waitcnt lgkmcnt(" #n ")" ::: "memory")
#define G_BAR __builtin_amdgcn_s_barrier()
#define G_SCHED __builtin_amdgcn_sched_barrier(0)
    Unit cur, nxt; int ui = 0;
    if (!p.unit(c, cur)) return;
    f32x4 acc[2][2][4][2];
    bf16x8 At[4][2], B0[2][2], B1[2][2];
    if (MODE == 2) {
#pragma unroll
        for (int m = 0; m < 4; ++m)
#pragma unroll
            for (int k = 0; k < 2; ++k) { At[m][k] = (bf16x8){(short)(0x3c00 + fr), 0x3f80, (short)0xbf80, 0x3e00, (short)(0x3d00 + fq), 0x3f00, (short)0xbe80, 0x3f80}; asm volatile("" : "+v"(At[m][k])); }
#pragma unroll
        for (int n = 0; n < 2; ++n)
#pragma unroll
            for (int k = 0; k < 2; ++k) { B0[n][k] = At[n][k]; B1[n][k] = At[n + 2][k]; asm volatile("" : "+v"(B0[n][k])); asm volatile("" : "+v"(B1[n][k])); }
    }
    const char* cA = p.a0(cur); const char* cB = p.b0(cur);
    const char* cA2 = P::SEG ? p.a1(cur) : cA; const char* cB2 = P::SEG ? p.b1(cur) : cB;
    G_STAGE_B(0, 0, cB, cB2, 0); G_STAGE_A(0, 0, cA, cA2, 0); G_STAGE_B(0, 1, cB, cB2, 0); G_STAGE_A(0, 1, cA, cA2, 0);
    if (wr == 1) G_BAR;
    G_WAIT_V(4); G_BAR;
    G_STAGE_B(1, 0, cB, cB2, 1); G_STAGE_A(1, 0, cA, cA2, 1); G_STAGE_B(1, 1, cB, cB2, 1);
    G_WAIT_V(6); G_BAR;
    for (;;) {
        const bool has_next = p.unit((ui + 1) * G + c, nxt);
        const char* nA = has_next ? p.a0(nxt) : cA; const char* nB = has_next ? p.b0(nxt) : cB;
        const char* nA2 = P::SEG ? (has_next ? p.a1(nxt) : cA2) : nA; const char* nB2 = P::SEG ? (has_next ? p.b1(nxt) : cB2) : nB;
#define G_PAIR(t, Z) do { \
            const bool last = ((t) == nt - 2); \
            const char* xA = last ? nA : cA; const char* xA2 = last ? nA2 : cA2; const char* xB = last ? nB : cB; const char* xB2 = last ? nB2 : cB2; \
            const int t2 = last ? 0 : (t) + 2, t3 = t2 + 1; \
              G_LDB(B0, 0, 0); G_SCHED; G_LDA(At, 0, 0); G_STAGE_A(1, 1, cA, cA2, (t) + 1); \
            G_WAIT_L(8); G_BAR; G_WAIT_L(0); G_MMA(0, 0, At, B0, Z); G_BAR; G_SCHED; \
              G_LDB(B1, 0, 1); G_STAGE_B(0, 0, xB, xB2, t2); \
            G_BAR; G_WAIT_L(0); G_MMA(0, 1, At, B1, Z); G_BAR; \
              G_LDA(At, 0, 1); G_STAGE_A(0, 0, xA, xA2, t2); \
            G_BAR; G_WAIT_L(0); G_MMA(1, 0, At, B0, Z); G_BAR; G_SCHED; \
              G_STAGE_B(0, 1, xB, xB2, t2); \
            G_WAIT_V(6); G_BAR; G_MMA(1, 1, At, B1, Z); G_BAR; \
              G_LDB(B0, 1, 0); G_SCHED; G_LDA(At, 1, 0); G_STAGE_A(0, 1, xA, xA2, t2); \
            G_WAIT_L(8); G_BAR; G_WAIT_L(0); G_MMA(0, 0, At, B0, 0); G_BAR; G_SCHED; \
              G_LDB(B1, 1, 1); G_STAGE_B(1, 0, xB, xB2, t3); \
            G_BAR; G_WAIT_L(0); G_MMA(0, 1, At, B1, 0); G_BAR; \
              G_LDA(At, 1, 1); G_STAGE_A(1, 0, xA, xA2, t3); \
            G_BAR; G_WAIT_L(0); G_MMA(1, 0, At, B0, 0); G_BAR; G_SCHED; \
              G_STAGE_B(1, 1, xB, xB2, t3); \
            G_WAIT_V(6); G_BAR; G_MMA(1, 1, At, B1, 0); G_BAR; } while (0)
        G_PAIR(0, 1);
#pragma unroll 1
        for (int t = 2; t < nt; t += 2) G_PAIR(t, 0);
        p.epi(acc, cur, wr, wc, fr, fq);
        if (!has_next) break;
        cur = nxt; cA = nA; cB = nB; cA2 = nA2; cB2 = nB2; ++ui;
    }
    G_WAIT_V(0);
    if (wr == 0) G_BAR;
    G_BAR;
#undef G_SA
#undef G_SB
#undef G_STAGE_A
#undef G_STAGE_B
#undef G_LDA
#undef G_LDB
#undef G_MMA
#undef G_PAIR
#undef G_WAIT_V
#undef G_WAIT_L
#undef G_BAR
#undef G_SCHED
}

struct ConvJob { const float* s0; ptrdiff_t d10; const float* gain; bf16_t* dst; int kind; int pad; };
__device__ __forceinline__ void conv_load(const float* src, int stride, float (&v)[8]) {
#pragma unroll
    for (int j = 0; j < 8; ++j) v[j] = src[(size_t)j * stride];
}
__device__ __forceinline__ void conv_store(bf16_t* dst, const float (&v)[8], const float* kgain, float nscale) {
    float g[8];
#pragma unroll
    for (int j = 0; j < 8; ++j) g[j] = kgain ? kgain[j] * nscale : nscale;
    u32x4 w; w.x = pk2(v[0] * g[0], v[1] * g[1]); w.y = pk2(v[2] * g[2], v[3] * g[3]); w.z = pk2(v[4] * g[4], v[5] * g[5]); w.w = pk2(v[6] * g[6], v[7] * g[7]);
    *(u32x4*)dst = w;
}
constexpr int NWI_GU = 88 * 128, NWI_DN = 16 * 352, NWI_GLU = 32 * 128, NWI_POOL = 16 * 32;
__device__ __forceinline__ void conv_addr(const ConvJob& j, int wi, int lane, const float*& src, int& stride, bf16_t*& dst, const float*& kg) {
    if (j.kind == 1) { const int rb = wi >> 7, k0 = (wi & 127) * 8, pn = rb >> 2, bj = (rb >> 1) & 1;
        src = j.s0 + (ptrdiff_t)bj * j.d10 + (size_t)k0 * FF + pn * 128 + (rb & 1) * 64 + lane; stride = FF; dst = j.dst + (size_t)(rb * 64 + lane) * D + k0; kg = j.gain + k0; }
    else { const int nb = wi / 352, k0 = (wi - nb * 352) * 8;
        src = j.s0 + (size_t)k0 * D + nb * 64 + lane; stride = D; dst = j.dst + (size_t)(nb * 64 + lane) * FF + k0; kg = nullptr; }
}
__device__ __forceinline__ ConvJob job_gu(const Params& P, int layer, int f) { ConvJob j; const size_t wo = ((size_t)layer * 2 + f) * (size_t)D * FF;
    j.s0 = P.wg + wo; j.d10 = P.wu - P.wg; j.gain = P.norm_g + ((size_t)layer * 3 + (f ? 2 : 0)) * D; j.dst = (bf16_t*)(P.ws + OFF_WGU); j.kind = 1; j.pad = 0; return j; }
__device__ __forceinline__ ConvJob job_dn(const Params& P, int layer, int f) { ConvJob j; const size_t wo = ((size_t)layer * 2 + f) * (size_t)D * FF;
    j.s0 = P.wd + wo; j.d10 = 0; j.gain = nullptr; j.dst = (bf16_t*)(P.ws + OFF_WD); j.kind = 2; j.pad = 0; return j; }
__device__ __forceinline__ ConvJob job_none() { ConvJob j; j.s0 = nullptr; j.d10 = 0; j.gain = nullptr; j.dst = nullptr; j.kind = 0; j.pad = 0; return j; }
template <int NJ>
struct ConvHost {
    float v[NJ][8]; bf16_t* dst[NJ]; const float* kg[NJ]; bool on[NJ];
    __device__ __forceinline__ void begin(const ConvJob& j, int L, int per, int wid, int lane) {
#pragma unroll
        for (int q = 0; q < NJ; ++q) { on[q] = j.kind != 0 && (wid + 8 * q) < per;
            if (on[q]) { const float* src; int stride; conv_addr(j, L * per + wid + 8 * q, lane, src, stride, dst[q], kg[q]); conv_load(src, stride, v[q]); } }
    }
    __device__ __forceinline__ void finish() {
#pragma unroll
        for (int q = 0; q < NJ; ++q) if (on[q]) conv_store(dst[q], v[q], kg[q], 1.0f);
    }
};

template <int NMAX>
__device__ __forceinline__ void conv_block(const ConvJob& j, int total, int gw, int NW, int lane) {
    if (j.kind == 0) return;
    float v[NMAX][8]; bf16_t* d[NMAX]; const float* kg[NMAX];
#pragma unroll
    for (int q = 0; q < NMAX; ++q) { const int wi = gw + q * NW; const float* src; int st;
        conv_addr(j, wi < total ? wi : gw, lane, src, st, d[q], kg[q]); conv_load(src, st, v[q]); }
#pragma unroll
    for (int q = 0; q < NMAX; ++q) if (gw + q * NW < total) conv_store(d[q], v[q], kg[q], 1.0f);
}

__device__ __forceinline__ void dry_epi(const f32x4 (&acc)[2][2][4][2], int flag, float* sink) {
    if (flag == 12345) { f32x4 s = (f32x4){0.f, 0.f, 0.f, 0.f};
#pragma unroll
        for (int a = 0; a < 2; ++a)
#pragma unroll
            for (int b = 0; b < 2; ++b)
#pragma unroll
                for (int m = 0; m < 4; ++m)
#pragma unroll
                    for (int n = 0; n < 2; ++n) s += acc[a][b][m][n];
        *(f32x4*)(sink + threadIdx.x * 4) = s; }
}
template <int LDA, int LDB, int NT_, bool PERM_>
struct PlainBase {
    static constexpr bool PERM = PERM_, SEG = false; static constexpr int NT = NT_, TS = 0;
    __device__ __forceinline__ ptrdiff_t kA() const { return 128; }
    __device__ __forceinline__ ptrdiff_t hA() const { return (ptrdiff_t)128 * LDA * 2; }
    __device__ __forceinline__ ptrdiff_t kB() const { return 128; }
    __device__ __forceinline__ ptrdiff_t hB() const { return (ptrdiff_t)128 * LDB * 2; }
    __device__ __forceinline__ ptrdiff_t kA2() const { return 0; }
    __device__ __forceinline__ ptrdiff_t hA2() const { return 0; }
    __device__ __forceinline__ ptrdiff_t kB2() const { return 0; }
    __device__ __forceinline__ ptrdiff_t hB2() const { return 0; }
    __device__ __forceinline__ int voffA(int R, int C) const { return (R * LDA + C) * 2; }
    __device__ __forceinline__ int voffB(int R, int C) const { return (R * LDB + C) * 2; }
    __device__ __forceinline__ int voffA2(int, int) const { return 0; }
    __device__ __forceinline__ int voffB2(int, int) const { return 0; }
    __device__ __forceinline__ const char* a1(const Unit&) const { return nullptr; }
    __device__ __forceinline__ const char* b1(const Unit&) const { return nullptr; }
};

struct GemmGU : PlainBase<D, D, 16, true> {
    const char* A; const char* B; bf16_t* H; const LAS float* rs_lds; int nq; int dry; ConvJob cj;
    __device__ __forceinline__ bool unit(int L, Unit& u) const { u.g = L; return order_mn(L, T / 256, NGU / 256, u.pm, u.pn); }
    __device__ __forceinline__ const char* a0(const Unit& u) const { return A + (((PROBE & 128) && dry) ? 0 : (size_t)u.pm * 256 * D * 2); }
    __device__ __forceinline__ const char* b0(const Unit& u) const { return B + (((PROBE & 128) && dry) ? 0 : (size_t)u.pn * 256 * D * 2); }
    __device__ __forceinline__ void epi(const f32x4 (&acc)[2][2][4][2], const Unit& u, int wr, int wc, int fr, int fq) const {
        if ((PROBE & 32) && dry) { dry_epi(acc, nq, (float*)H); return; }
        const int row0 = u.pm * 256 + wr * 64 + fr, col0 = u.pn * 128 + wc * 32 + 8 * fq;
#pragma unroll
        for (int ai = 0; ai < 2; ++ai)
#pragma unroll
            for (int m = 0; m < 4; ++m) {
                const int row = row0 + ai * 128 + m * 16; const float rs = rs_lds[((u.pm >> 3) & 1) * 256 + (row & 255)];
                const float rs2 = rs * -1.4426950408889634f, rsq = rs * rs;
                f32x2 v[4];
#pragma unroll
                for (int n = 0; n < 2; ++n)
#pragma unroll
                    for (int jp = 0; jp < 2; ++jp) {
                        const f32x2 gg = (f32x2){acc[ai][0][m][n][2 * jp], acc[ai][0][m][n][2 * jp + 1]}, uu = (f32x2){acc[ai][1][m][n][2 * jp], acc[ai][1][m][n][2 * jp + 1]};
                        const f32x2 t = gg * rs2; f32x2 e; e.x = __builtin_amdgcn_exp2f(t.x); e.y = __builtin_amdgcn_exp2f(t.y);
                        const f32x2 d = e + 1.0f; f32x2 r; r.x = __builtin_amdgcn_rcpf(d.x); r.y = __builtin_amdgcn_rcpf(d.y);
                        v[n * 2 + jp] = (gg * uu) * (r * rsq);
                    }
                u32x4 w; w.x = pk2(v[0].x, v[0].y); w.y = pk2(v[1].x, v[1].y); w.z = pk2(v[2].x, v[2].y); w.w = pk2(v[3].x, v[3].y);
                *(u32x4*)(H + (size_t)row * FF + col0) = w;
            }
    }
};

__device__ __forceinline__ float bf_lo(unsigned w) { return __builtin_bit_cast(float, w << 16); }
__device__ __forceinline__ float bf_hi(unsigned w) { return __builtin_bit_cast(float, w & 0xffff0000u); }
template <int LDA, int LDB, int NT_>
struct GemmResid : PlainBase<LDA, LDB, NT_, true> {
    const char* A; const char* B; bf16_t* xb; float* rowss; float coef; int pool; ConvJob cj;
    __device__ __forceinline__ bool unit(int L, Unit& u) const { u.g = L; return order_mn(L, T / 256, D / 256, u.pm, u.pn); }
    __device__ __forceinline__ const char* a0(const Unit& u) const { return A + ((size_t)u.pm * 256 * LDA + (pool ? (size_t)u.pn * 256 : 0)) * 2; }
    __device__ __forceinline__ const char* b0(const Unit& u) const { return B + (size_t)u.pn * 256 * LDB * 2; }
    __device__ __forceinline__ void epi(const f32x4 (&acc)[2][2][4][2], const Unit& u, int wr, int wc, int fr, int fq) const {
        if ((PROBE & 64) && coef == 0.f) { dry_epi(acc, pool, rowss); return; }
        const int row0 = u.pm * 256 + wr * 64 + fr, col0 = u.pn * 256 + wc * 32 + 8 * fq;
#pragma unroll
        for (int ai = 0; ai < 2; ++ai) {
            u32x4 xo[4][2];
#pragma unroll
            for (int m = 0; m < 4; ++m)
#pragma unroll
                for (int bj = 0; bj < 2; ++bj) xo[m][bj] = *(const u32x4*)(xb + (size_t)(row0 + ai * 128 + m * 16) * D + col0 + bj * 128);
#pragma unroll
            for (int m = 0; m < 4; ++m) {
                const int row = row0 + ai * 128 + m * 16; const size_t off = (size_t)row * D + col0; float ss = 0.f;
#pragma unroll
                for (int bj = 0; bj < 2; ++bj) {
                    const u32x4 o = xo[m][bj]; const f32x4 a0v = acc[ai][bj][m][0], a1v = acc[ai][bj][m][1];
                    const float v0 = bf_lo(o.x) + coef * a0v[0], v1 = bf_hi(o.x) + coef * a0v[1], v2 = bf_lo(o.y) + coef * a0v[2], v3 = bf_hi(o.y) + coef * a0v[3];
                    const float v4 = bf_lo(o.z) + coef * a1v[0], v5 = bf_hi(o.z) + coef * a1v[1], v6 = bf_lo(o.w) + coef * a1v[2], v7 = bf_hi(o.w) + coef * a1v[3];
                    u32x4 w; w.x = pk2(v0, v1); w.y = pk2(v2, v3); w.z = pk2(v4, v5); w.w = pk2(v6, v7);
                    *(u32x4*)(xb + off + bj * 128) = w;
                    ss += ((v0 * v0 + v1 * v1) + (v2 * v2 + v3 * v3)) + ((v4 * v4 + v5 * v5) + (v6 * v6 + v7 * v7));
                }
                ss += __shfl_xor(ss, 16); ss += __shfl_xor(ss, 32);
                if (fq == 0) rowss[(size_t)row * 32 + u.pn * 4 + wc] = ss;
            }
            asm volatile("" ::: "memory");
        }
    }
};

struct GemmGLU : PlainBase<D, D, 16, true> {
    const char* A; const char* B; bf16_t* xb; float* rowss; float coef;
    __device__ __forceinline__ bool unit(int L, Unit& u) const { u.g = 0; return order_mn(L, T / 256, 8, u.pm, u.pn); }
    __device__ __forceinline__ const char* a0(const Unit& u) const { return A + (size_t)u.pm * 256 * D * 2; }
    __device__ __forceinline__ const char* b0(const Unit& u) const { return B + (size_t)u.pn * 256 * D * 2; }
    __device__ __forceinline__ void epi(const f32x4 (&acc)[2][2][4][2], const Unit& u, int wr, int wc, int fr, int fq) const {
        const int row0 = u.pm * 256 + wr * 64 + fr, col0 = u.pn * 128 + wc * 32 + 8 * fq;
#pragma unroll
        for (int ai = 0; ai < 2; ++ai) {
            u32x4 xo[4];
#pragma unroll
            for (int m = 0; m < 4; ++m) xo[m] = *(const u32x4*)(xb + (size_t)(row0 + ai * 128 + m * 16) * D + col0);
#pragma unroll
            for (int m = 0; m < 4; ++m) {
                const int row = row0 + ai * 128 + m * 16; const size_t off = (size_t)row * D + col0;
                const u32x4 o = xo[m]; const f32x4 a0v = acc[ai][0][m][0], a1v = acc[ai][0][m][1], b0v = acc[ai][1][m][0], b1v = acc[ai][1][m][1];
                const float v0 = bf_lo(o.x) + coef * a0v[0] * fast_sigmoid(b0v[0]), v1 = bf_hi(o.x) + coef * a0v[1] * fast_sigmoid(b0v[1]);
                const float v2 = bf_lo(o.y) + coef * a0v[2] * fast_sigmoid(b0v[2]), v3 = bf_hi(o.y) + coef * a0v[3] * fast_sigmoid(b0v[3]);
                const float v4 = bf_lo(o.z) + coef * a1v[0] * fast_sigmoid(b1v[0]), v5 = bf_hi(o.z) + coef * a1v[1] * fast_sigmoid(b1v[1]);
                const float v6 = bf_lo(o.w) + coef * a1v[2] * fast_sigmoid(b1v[2]), v7 = bf_hi(o.w) + coef * a1v[3] * fast_sigmoid(b1v[3]);
                u32x4 w; w.x = pk2(v0, v1); w.y = pk2(v2, v3); w.z = pk2(v4, v5); w.w = pk2(v6, v7);
                *(u32x4*)(xb + off) = w;
                float ss = ((v0 * v0 + v1 * v1) + (v2 * v2 + v3 * v3)) + ((v4 * v4 + v5 * v5) + (v6 * v6 + v7 * v7));
                ss += __shfl_xor(ss, 16); ss += __shfl_xor(ss, 32);
                if (fq == 0) rowss[(size_t)row * 32 + u.pn * 4 + wc] = ss;
            }
            asm volatile("" ::: "memory");
        }
    }
};

struct GemmSend : PlainBase<D, D, 8, false> {
    const char* A; const char* B; float* Send;
    __device__ __forceinline__ bool unit(int L, Unit& u) const { if (L >= NG * 4) return false; u.g = L >> 2; u.pm = (L >> 1) & 1; u.pn = L & 1; return true; }
    __device__ __forceinline__ const char* a0(const Unit& u) const { return A + (((size_t)u.g * NCH + u.pm * 256) * D + u.pn * 512) * 2; }
    __device__ __forceinline__ const char* b0(const Unit& u) const { return B + ((size_t)u.g * 256 * D + u.pn * 512) * 2; }
    __device__ __forceinline__ void epi(const f32x4 (&acc)[2][2][4][2], const Unit& u, int wr, int wc, int fr, int fq) const {
        const int row0 = u.pm * 256 + wr * 64 + fr, col0 = wc * 32 + 4 * fq;
#pragma unroll
        for (int ai = 0; ai < 2; ++ai)
#pragma unroll
            for (int m = 0; m < 4; ++m) {
                float* rowp = Send + (size_t)u.pn * NG * NCH * 256 + ((size_t)u.g * NCH + row0 + ai * 128 + m * 16) * 256 + col0;
#pragma unroll
                for (int bj = 0; bj < 2; ++bj)
#pragma unroll
                    for (int n = 0; n < 2; ++n) *(f32x4*)(rowp + bj * 128 + n * 16) = acc[ai][bj][m][n];
            }
    }
};

struct GemmToep {
    static constexpr bool PERM = true, SEG = true; static constexpr int NT = 20, TS = 16;
    const char* Ug; const char* Sin; const char* Kc; const char* Wc; bf16_t* gact;
    __device__ __forceinline__ ptrdiff_t kA() const { return 128; }
    __device__ __forceinline__ ptrdiff_t hA() const { return (ptrdiff_t)128 * D * 2; }
    __device__ __forceinline__ ptrdiff_t kB() const { return -2048; }
    __device__ __forceinline__ ptrdiff_t hB() const { return 4096; }
    __device__ __forceinline__ ptrdiff_t kA2() const { return 128; }
    __device__ __forceinline__ ptrdiff_t hA2() const { return (ptrdiff_t)128 * 256 * 2; }
    __device__ __forceinline__ ptrdiff_t kB2() const { return 128; }
    __device__ __forceinline__ ptrdiff_t hB2() const { return (ptrdiff_t)128 * 256 * 2; }
    __device__ __forceinline__ int voffA(int R, int C) const { return (R * D + C) * 2; }
    __device__ __forceinline__ int voffB(int R, int C) const { return (((R >> 4) - (C >> 4)) * 256 + (R & 15) * 16 + (C & 15)) * 2; }
    __device__ __forceinline__ int voffA2(int R, int C) const { return (R * 256 + C) * 2; }
    __device__ __forceinline__ int voffB2(int R, int C) const { return (R * 256 + C) * 2; }
    __device__ __forceinline__ bool unit(int L, Unit& u) const { if (L >= NG * 8) return false; u.g = L >> 3; u.pm = (L >> 2) & 1; u.pn = L & 3; return true; }
    __device__ __forceinline__ const char* a0(const Unit& u) const { return Ug + ((size_t)u.g * NCH + u.pm * 256) * D * 2; }
    __device__ __forceinline__ const char* a1(const Unit& u) const { return Sin + ((size_t)u.g * NCH + u.pm * 256) * 256 * 2; }
    __device__ __forceinline__ const char* b0(const Unit& u) const { return Kc + ((size_t)u.g * 127 + 16 * u.pn + 63) * 512; }
    __device__ __forceinline__ const char* b1(const Unit& u) const { return Wc + ((size_t)u.g * 1024 + u.pn * 256) * 256 * 2; }
    __device__ __forceinline__ void epi(const f32x4 (&acc)[2][2][4][2], const Unit& u, int wr, int wc, int fr, int fq) const {
        const int ch0 = u.pm * 256 + wr * 64 + fr;
#pragma unroll
        for (int ai = 0; ai < 2; ++ai)
#pragma unroll
            for (int m = 0; m < 4; ++m) {
                const int chunk = ch0 + ai * 128 + m * 16;
#pragma unroll
                for (int bj = 0; bj < 2; ++bj) {
                    const int tl = 16 * u.pn + 8 * bj + 2 * wc + (fq >> 1);
                    float v[8];
#pragma unroll
                    for (int n = 0; n < 2; ++n)
#pragma unroll
                        for (int j = 0; j < 4; ++j) { const float y = acc[ai][bj][m][n][j]; v[n * 4 + j] = y * fast_sigmoid(1.5957691216f * (y + 0.044715f * y * y * y)); }
                    u32x4 w; w.x = pk2(v[0], v[1]); w.y = pk2(v[2], v[3]); w.z = pk2(v[4], v[5]); w.w = pk2(v[6], v[7]);
                    *(u32x4*)(gact + ((size_t)chunk * LC + tl) * D + u.g * 16 + 8 * (fq & 1)) = w;
                }
            }
    }
};

__device__ __forceinline__ void sincos_d(double ang, double& s, double& c) {
    const double k = rint(ang * 0.15915494309189533577); const double r = fma(-k, 6.283185307179586476925, ang); const double r2 = r * r;
    double ts = r, tc = 1.0; s = r; c = 1.0;
#pragma unroll
    for (int n = 1; n <= 14; ++n) { tc *= -r2 * (1.0 / (double)((2 * n - 1) * (2 * n))); c += tc; ts *= -r2 * (1.0 / (double)((2 * n) * (2 * n + 1))); s += ts; }
}
__device__ __forceinline__ void s5_tables(const Params& P, int g, int part, unsigned char* lds) {
    f32x2* pw = (f32x2*)lds; f32x2* Chp = (f32x2*)(lds + 67584); f32x2* Cph = (f32x2*)(lds + 83968); f32x2* Bb = (f32x2*)(lds + 100352); f32x2* kf = (f32x2*)(lds + 116736);
    const int tid = threadIdx.x;
    {
        const int dir = tid >> 8, p = (tid >> 2) & 63, q = tid & 3;
        const double lr = (double)P.lam_re[(dir * NG + g) * 64 + p], li = (double)P.lam_im[(dir * NG + g) * 64 + p], step = exp((double)P.log_step[dir * NG + g]);
        const double zr = lr * step, th = li * step;
        for (int e = q; e <= 64; e += 4) { double s, c; sincos_d(th * e, s, c); const double mag = exp(zr * e); pw[(dir * 64 + p) * 66 + e] = (f32x2){(float)(mag * c), (float)(mag * s)}; }
        if (q == 0) { double s, c; sincos_d(th, s, c); const double mag = exp(zr), ar = mag * c, ai = mag * s, nr = ar - 1.0, den = lr * lr + li * li;
            kf[dir * 64 + p] = (f32x2){(float)((nr * lr + ai * li) / den), (float)((ai * lr - nr * li) / den)}; }
    }
    __syncthreads();
    for (int i = tid; i < 2048; i += 512) {
        const int dir = i >> 10, p = (i >> 4) & 63, h = i & 15;
        const size_t bi = (((size_t)dir * NG + g) * 64 + p) * 16 + h;
        const f32x2 k = kf[dir * 64 + p]; const float br = P.b_re[bi], bim = P.b_im[bi];
        Bb[(dir * 64 + p) * 16 + h] = (f32x2){k.x * br - k.y * bim, k.x * bim + k.y * br};
        const size_t ci = (((size_t)dir * NG + g) * 16 + h) * 64 + p;
        const f32x2 cv = (f32x2){P.c_re[ci], P.c_im[ci]};
        Chp[(dir * 16 + h) * 64 + p] = cv; Cph[(dir * 64 + p) * 16 + h] = cv;
    }
    __syncthreads();
    if (part < 2) {
        bf16_t* Kc = (bf16_t*)(P.ws + OFF_KC) + (size_t)g * 127 * 256;
        if (part == 0 && tid < 128) { const int dir = tid >> 6, p = tid & 63; ((f32x2*)(P.ws + OFF_AL))[(g * 2 + dir) * 64 + p] = pw[(dir * 64 + p) * 66 + 64]; }
        const int jbase = part ? 64 : 0, nitem = part ? 63 * 16 : 64 * 16;
        for (int idx = tid; idx < nitem; idx += 512) {
            const int jj = jbase + (idx >> 4), h = idx & 15, j = jj - 63;
            float a[16];
#pragma unroll
            for (int k = 0; k < 16; ++k) a[k] = 0.f;
            if (j >= 0) {
                for (int p = 0; p < 64; ++p) { const f32x2 cv = Cph[p * 16 + h], w = pw[p * 66 + j]; const float cwr = cv.x * w.x - cv.y * w.y, cwi = cv.x * w.y + cv.y * w.x;
#pragma unroll
                    for (int k = 0; k < 16; ++k) { const f32x2 b = Bb[p * 16 + k]; a[k] += cwr * b.x - cwi * b.y; } }
            }
            if (j <= 0) {
                for (int p = 0; p < 64; ++p) { const f32x2 cv = Cph[(64 + p) * 16 + h], w = pw[(64 + p) * 66 - j]; const float cwr = cv.x * w.x - cv.y * w.y, cwi = cv.x * w.y + cv.y * w.x;
#pragma unroll
                    for (int k = 0; k < 16; ++k) { const f32x2 b = Bb[(64 + p) * 16 + k]; a[k] += cwr * b.x - cwi * b.y; } }
            }
            if (j == 0) { const float dv = P.s5d[g * 16 + h];
#pragma unroll
                for (int k = 0; k < 16; ++k) a[k] += (k == h) ? dv : 0.f; }
            u32x4 w0, w1; w0.x = pk2(a[0], a[1]); w0.y = pk2(a[2], a[3]); w0.z = pk2(a[4], a[5]); w0.w = pk2(a[6], a[7]); w1.x = pk2(a[8], a[9]); w1.y = pk2(a[10], a[11]); w1.z = pk2(a[12], a[13]); w1.w = pk2(a[14], a[15]);
            u32x4* dst = (u32x4*)(Kc + ((size_t)jj * 16 + h) * 16); dst[0] = w0; dst[1] = w1;
        }
    } else if (part == 2) {
        bf16_t* Wc = (bf16_t*)((unsigned char*)P.out + OUT_WC) + (size_t)g * 1024 * 256;
        const int w = tid >> 6, p = tid & 63;
        for (int it = w; it < 2048; it += 8) {
            const int dir = it & 1, h = (it >> 1) & 15, tl = it >> 5, e = dir ? 64 - tl : tl + 1;
            const f32x2 cv = Chp[(dir * 16 + h) * 64 + p], a = pw[(dir * 64 + p) * 66 + e];
            const float zr = cv.x * a.x - cv.y * a.y, zi = cv.x * a.y + cv.y * a.x;
            bf16_t* d = Wc + (size_t)(tl * 16 + h) * 256 + dir * 128 + p;
            d[0] = (bf16_t)f2bf(zr); d[64] = (bf16_t)f2bf(-zi);
        }
    } else {
        bf16_t* We = (bf16_t*)((unsigned char*)P.out + OUT_WEND) + (size_t)g * 256 * 1024;
        const int s = tid >> 3, h0 = (tid & 7) * 2;
        for (int it = 0; it < 128; ++it) {
            const int dir = it >> 6, p = it & 63, e = dir ? s : 63 - s;
            const f32x2 a = pw[(dir * 64 + p) * 66 + e], b0 = Bb[(dir * 64 + p) * 16 + h0], b1 = Bb[(dir * 64 + p) * 16 + h0 + 1];
            const float z0r = a.x * b0.x - a.y * b0.y, z0i = a.x * b0.y + a.y * b0.x, z1r = a.x * b1.x - a.y * b1.y, z1i = a.x * b1.y + a.y * b1.x;
            bf16_t* d = We + (size_t)(dir * 128 + p) * 1024 + s * 16 + h0;
            *(unsigned*)d = pk2(z0r, z1r); *(unsigned*)(d + 64 * 1024) = pk2(z0i, z1i);
        }
    }
    __syncthreads();
}

#define XB_TMO      128
#define XB_XCNT(j)  (256  + 64 * (j))
#define XB_XSUB(j)  (1280 + 64 * (j))
#define XB_XGEN(j)  (2304 + 64 * (j))
#define XB_TOP      3328
#define XB_TOPGEN   3392
#define XCD_BAR_WORDS 3456
#define XB_SPIN_CAP (1u << 22)
__device__ __forceinline__ unsigned xb_ld(unsigned* p)              { return __hip_atomic_load(p, __ATOMIC_RELAXED, __HIP_MEMORY_SCOPE_AGENT); }
__device__ __forceinline__ unsigned xb_add(unsigned* p, unsigned v) { return __hip_atomic_fetch_add(p, v, __ATOMIC_RELAXED, __HIP_MEMORY_SCOPE_AGENT); }
__device__ __forceinline__ unsigned xb_xcc_id() { return (unsigned)__builtin_amdgcn_s_getreg((3 << 11) | 20) & 0xFu; }
#define XB_SPIN(cond, bar) do { unsigned _sp = 0; while (cond) { __builtin_amdgcn_s_sleep(1); \
    if ((++_sp & 255u) == 0u) { if (xb_ld(&(bar)[XB_TMO])) break; if (_sp > XB_SPIN_CAP) { atomicAdd(&(bar)[XB_TMO], 1u); break; } } } } while (0)
__device__ __forceinline__ void xcd_barrier_complete(unsigned* bar, unsigned x, unsigned& nloc, unsigned& nx) {
    const unsigned G = gridDim.x * gridDim.y * gridDim.z;
    unsigned sum, cnt, mine, sp = 0u;
    for (;;) {
        sum = 0u; cnt = 0u; mine = 0u;
#pragma unroll
        for (unsigned j = 0; j < 16; ++j) { const unsigned c = xb_ld(&bar[XB_XCNT(j)]); sum += c; cnt += (c > 0u) ? 1u : 0u; mine = (j == x) ? c : mine; }
        if (sum == G) break;
        __builtin_amdgcn_s_sleep(1);
        if ((++sp & 255u) == 0u) { if (xb_ld(&bar[XB_TMO])) break; if (sp > XB_SPIN_CAP) { atomicAdd(&bar[XB_TMO], 1u); break; } }
    }
    nloc = mine > 0u ? mine : 1u; nx = cnt > 0u ? cnt : 1u;
}
__device__ __forceinline__ void xcd_barrier(unsigned* bar, volatile LAS unsigned* st) {
    asm volatile("s_waitcnt vmcnt(0)" ::: "memory");
    __syncthreads();
    if (threadIdx.x == 0) {
        __builtin_amdgcn_s_waitcnt(0);
        const unsigned x = xb_xcc_id();
        unsigned nloc = st[0], nx = st[1];
        if (nloc == 0u) {
            xcd_barrier_complete(bar, x, nloc, nx); st[0] = nloc; st[1] = nx;
            unsigned rank = st[2];
            for (unsigned j = 0; j < 16; ++j) if (j < x) rank += xb_ld(&bar[XB_XCNT(j)]);
            const unsigned G = gridDim.x, per = (G + nx - 1) / nx;
            st[3] = (G % 8 == 0 && nx == 8) ? (rank % per) * 8 + rank / per : rank;
        }
        const unsigned old = xb_add(&bar[XB_XSUB(x)], 1u);
        const unsigned gen = old / nloc;
        if (old + 1u == (gen + 1u) * nloc) {
            __builtin_amdgcn_fence(__ATOMIC_RELEASE, "agent");
            asm volatile("s_waitcnt vmcnt(0)" ::: "memory");
            const unsigned og = xb_add(&bar[XB_TOP], 1u);
            const unsigned tg = og / nx;
            if (og + 1u == (tg + 1u) * nx) xb_add(&bar[XB_TOPGEN], 1u);
            else XB_SPIN(xb_ld(&bar[XB_TOPGEN]) == tg, bar);
            __builtin_amdgcn_fence(__ATOMIC_ACQUIRE, "agent");
            xb_add(&bar[XB_XGEN(x)], 1u);
            asm volatile("s_waitcnt vmcnt(0)" ::: "memory");
        } else {
            XB_SPIN(xb_ld(&bar[XB_XGEN(x)]) == gen, bar);
            __builtin_amdgcn_fence(__ATOMIC_ACQUIRE, "agent");
            asm volatile("s_waitcnt vmcnt(0)" ::: "memory");
        }
    }
    __syncthreads();
}

__global__ void __launch_bounds__(512, 2) fwd_megakernel(Params Pk) {
    extern __shared__ __attribute__((aligned(16))) unsigned char lds_raw[];
    LAS unsigned char* lds = (LAS unsigned char*)lds_raw;
    cg::grid_group grid = cg::this_grid();
    const int G = gridDim.x;
    const int lo = Pk.ph_lo, hi = Pk.ph_hi;
    volatile LAS unsigned* misc = (volatile LAS unsigned*)(lds + LDS_MISC);
    unsigned* barw = (unsigned*)(Pk.ws + OFF_BAR);
    if (threadIdx.x < 4) misc[threadIdx.x] = (threadIdx.x == 3) ? blockIdx.x : 0u;
    __syncthreads();
    if (ONE_LAUNCH && threadIdx.x == 0) misc[2] = xb_add(&barw[XB_XCNT(xb_xcc_id())], 1u);
    if (hi == 12345) grid.sync();
#if defined(__HIP_DEVICE_COMPILE__)
#define LOAD_PARAMS const __attribute__((address_space(4))) Params* _pp = (const __attribute__((address_space(4))) Params*)__builtin_amdgcn_kernarg_segment_ptr(); asm volatile("" : "+s"(_pp)); const Params P = *_pp;
#else
#define LOAD_PARAMS const Params P = Pk;
#endif
#define PHASE_VARS \
    LOAD_PARAMS \
    const int tid = opaque_tid(), lane = tid & 63, wid = tid >> 6, bx = (int)misc[3], gw = bx * 8 + wid, NW = G * 8; (void)lane; (void)gw; (void)NW; \
    unsigned char* ws = P.ws; bf16_t* xb = (bf16_t*)(ws + OFF_XB); bf16_t* Hb = (bf16_t*)(ws + OFF_H); float* rowss = (float*)(ws + OFF_ROWSS); float* x = P.out; \
    const float* xin_hi = P.xin1 - (size_t)TP * D; (void)xb; (void)Hb; (void)rowss; (void)x; (void)xin_hi;
#define PHASE(k) if (lo <= (k) && (k) < hi) for (int rep = 0; rep < nrep(k); ++rep)
#define LASTREP(k) (rep + 1 >= nrep(k))
#define SEAM(k) do { if (!LASTREP(k) || (k) + 1 < hi) xcd_barrier((unsigned*)(P.ws + OFF_BAR), misc); if (PROBE & 16) xcd_barrier((unsigned*)(P.ws + OFF_BAR), misc); } while (0)

    PHASE(0) { PHASE_VARS
        if (bx & 1) for (int it = bx; it < NG * 4; it += G) s5_tables(P, it >> 2, it & 3, lds_raw);
        for (int row = gw; row < T; row += 4 * NW) {
            f32x4 v[4][4];
#pragma unroll
            for (int r = 0; r < 4; ++r) { const int rr = (row + r * NW) < T ? (row + r * NW) : row; const float* src = (rr < TP ? P.xin0 : xin_hi) + (size_t)rr * D;
#pragma unroll
                for (int k = 0; k < 4; ++k) v[r][k] = *(const f32x4*)(src + k * 256 + lane * 4); }
#pragma unroll
            for (int r = 0; r < 4; ++r) { const int rr = (row + r * NW) < T ? (row + r * NW) : row; float ss = 0.f;
#pragma unroll
                for (int k = 0; k < 4; ++k) { const f32x4 q = v[r][k]; ss += (q[0] * q[0] + q[1] * q[1]) + (q[2] * q[2] + q[3] * q[3]);
                    u32x2 w; w.x = pk2(q[0], q[1]); w.y = pk2(q[2], q[3]); *(u32x2*)(xb + (size_t)rr * D + k * 256 + lane * 4) = w; }
                ss = wave_sum(ss);
                if (lane < 4) rowss[(size_t)rr * 32 + lane] = lane == 0 ? ss : 0.f; }
        }
        {
            const ConvJob j = job_gu(P, 0, 0);
            for (int wi = gw; wi < NWI_GU + NWI_GLU + NWI_POOL; wi += NW) {
                const float* src; int stride; bf16_t* dst; const float* kg = nullptr; float ns = 1.0f;
                if (wi < NWI_GU) conv_addr(j, wi, lane, src, stride, dst, kg);
                else if (wi < NWI_GU + NWI_GLU) { const int w2 = wi - NWI_GU, rb = w2 >> 7, k0 = (w2 & 127) * 8, pn = rb >> 2, bj = (rb >> 1) & 1;
                    src = P.glu_a + (ptrdiff_t)bj * (P.glu_b - P.glu_a) + (size_t)k0 * D + pn * 128 + (rb & 1) * 64 + lane; stride = D; dst = (bf16_t*)(ws + OFF_WGLU) + (size_t)(rb * 64 + lane) * D + k0; }
                else { const int w2 = wi - NWI_GU - NWI_GLU, rb = w2 >> 5, k0 = (w2 & 31) * 8, g = rb >> 2, d0 = (rb & 3) * 64;
                    src = P.pool_w + (size_t)g * 65536 + (size_t)k0 * 256 + d0 + lane; stride = 256; dst = (bf16_t*)(ws + OFF_WPOOL) + (size_t)(rb * 64 + lane) * 256 + k0; ns = P.pool_scale[g * 256 + d0 + lane]; }
                float v[8]; conv_load(src, stride, v); conv_store(dst, v, kg, ns);
            }
        }
        if (!(bx & 1)) for (int it = bx; it < NG * 4; it += G) s5_tables(P, it >> 2, it & 3, lds_raw);
        SEAM(0);
    }
#define PH_GU(k, nq_, cjob) PHASE(k) { PHASE_VARS GemmGU g; g.cj = job_none(); if (LASTREP(k) && (bx & 1)) conv_block<3>((cjob), NWI_DN, gw, NW, lane); g.A = (const char*)xb; g.B = (const char*)(ws + OFF_WGU); g.H = Hb; g.rs_lds = (const LAS float*)(lds + LDS_RS); g.nq = (nq_); g.dry = !LASTREP(k); \
        { const int pmr = 16 * (bx & 7) + ((bx >> 3) & 7) + 8 * (tid >> 8); ((LAS float*)(lds + LDS_RS))[tid] = row_rstd(rowss, pmr * 256 + (tid & 255), (nq_)); __syncthreads(); } \
        if ((PROBE & 1024) && g.dry && (bx & 8)) { } else if ((PROBE & 768) && g.dry) gemm_phase<GemmGU, (PROBE >> 8) & 3>(lds, g, G, bx); else gemm_phase(lds, g, G, bx); if (LASTREP(k) && !(bx & 1)) conv_block<3>((cjob), NWI_DN, gw, NW, lane); SEAM(k); }
#define PH_DN(k, cjob) PHASE(k) { PHASE_VARS GemmResid<FF, FF, 44> g; g.cj = job_none(); if (LASTREP(k) && (bx & 1)) conv_block<6>((cjob), NWI_GU, gw, NW, lane); g.A = (const char*)Hb; g.B = (const char*)(ws + OFF_WD); g.xb = xb; g.rowss = rowss; g.coef = LASTREP(k) ? 0.5f : 0.f; g.pool = 0; gemm_phase(lds, g, G, bx); if (LASTREP(k) && !(bx & 1)) conv_block<6>((cjob), NWI_GU, gw, NW, lane); SEAM(k); }
    PH_GU(1, 1, job_dn(P, 0, 0))
    PH_DN(2, job_gu(P, 0, 1))
    PHASE(3) { PHASE_VARS
        bf16_t* Ug = (bf16_t*)P.out; const float* g1 = P.norm_g + 1 * D;
        f32x4 gv[4];
#pragma unroll
        for (int k = 0; k < 4; ++k) gv[k] = *(const f32x4*)(g1 + lane * 16 + k * 4);
        for (int base = gw * 4; base < T; base += NW * 4) {
            u32x4 q[4][2];
#pragma unroll
            for (int r = 0; r < 4; ++r) { const u32x4* src = (const u32x4*)(xb + (size_t)(base + r) * D + lane * 16); q[r][0] = src[0]; q[r][1] = src[1]; }
#pragma unroll
            for (int r = 0; r < 4; ++r) { const int row = base + r; const u32x4 q0 = q[r][0], q1 = q[r][1]; float v[16];
                v[0] = bf_lo(q0.x); v[1] = bf_hi(q0.x); v[2] = bf_lo(q0.y); v[3] = bf_hi(q0.y); v[4] = bf_lo(q0.z); v[5] = bf_hi(q0.z); v[6] = bf_lo(q0.w); v[7] = bf_hi(q0.w);
                v[8] = bf_lo(q1.x); v[9] = bf_hi(q1.x); v[10] = bf_lo(q1.y); v[11] = bf_hi(q1.y); v[12] = bf_lo(q1.z); v[13] = bf_hi(q1.z); v[14] = bf_lo(q1.w); v[15] = bf_hi(q1.w);
                float ss = 0.f;
#pragma unroll
                for (int k = 0; k < 16; ++k) ss += v[k] * v[k];
                ss = wave_sum(ss); const float rs = __builtin_amdgcn_rsqf(ss * (1.0f / 1024.0f) + EPS);
#pragma unroll
                for (int k = 0; k < 16; ++k) v[k] *= rs * gv[k >> 2][k & 3];
                u32x4 w0, w1;
                w0.x = pk2(v[0], v[1]); w0.y = pk2(v[2], v[3]); w0.z = pk2(v[4], v[5]); w0.w = pk2(v[6], v[7]);
                w1.x = pk2(v[8], v[9]); w1.y = pk2(v[10], v[11]); w1.z = pk2(v[12], v[13]); w1.w = pk2(v[14], v[15]);
                u32x4* dst = (u32x4*)(Ug + ((size_t)lane * NCH + (row >> 6)) * D + (row & 63) * 16); dst[0] = w0; dst[1] = w1; }
        }
        SEAM(3);
    }
    PHASE(4) { PHASE_VARS GemmSend g; g.A = (const char*)P.out; g.B = (const char*)P.out + OUT_WEND; g.Send = (float*)(ws + OFF_SEND); gemm_phase(lds, g, G, bx); SEAM(4); }
    PHASE(5) { PHASE_VARS
        const float* Send = (const float*)(ws + OFF_SEND); bf16_t* Sin = (bf16_t*)(ws + OFF_SIN); const f32x2* aL = (const f32x2*)(ws + OFF_AL); f32x2* endst = (f32x2*)lds_raw;
        constexpr size_t HALF2 = (size_t)NG * NCH * 256;
        for (int task = bx; task < NG * 4; task += G) {
            const int g = task >> 2, dir = (task >> 1) & 1, kind = task & 1;
            const f32x2 a = aL[(g * 2 + dir) * 64 + lane];
            const float* E = Send + (size_t)g * NCH * 256 + dir * 128 + lane; bf16_t* S = Sin + (size_t)g * NCH * 256 + dir * 128 + lane;
            const int cfirst = kind ? (dir ? 256 + 32 * wid + 31 : 256 + 32 * wid) : (dir ? 255 - 32 * wid : 32 * wid), cstep = dir ? -1 : 1;
            float sr = 0.f, si = 0.f;
            if (kind == 0) {
#pragma unroll 8
                for (int i = 0; i < 32; ++i) { const size_t o = (size_t)(cfirst + cstep * i) * 256;
                    const float er = E[o] + E[o + HALF2], ei = E[o + 64] + E[o + 64 + HALF2];
                    const float nr = a.x * sr - a.y * si + er, ni = a.x * si + a.y * sr + ei; sr = nr; si = ni; }
                endst[wid * 64 + lane] = (f32x2){sr, si};
            }
            __syncthreads();
            sr = 0.f; si = 0.f;
            if (kind == 0) {
                f32x2 as = a;
#pragma unroll
                for (int q = 0; q < 5; ++q) as = (f32x2){as.x * as.x - as.y * as.y, 2.f * as.x * as.y};
                for (int r = 0; r < wid; ++r) { const f32x2 e = endst[r * 64 + lane]; const float nr = as.x * sr - as.y * si + e.x, ni = as.x * si + as.y * sr + e.y; sr = nr; si = ni; }
            }
#pragma unroll 8
            for (int i = 0; i < 32; ++i) { const size_t o = (size_t)(cfirst + cstep * i) * 256;
                const float er = E[o] + E[o + HALF2], ei = E[o + 64] + E[o + 64 + HALF2];
                S[o] = (bf16_t)f2bf(sr); S[o + 64] = (bf16_t)f2bf(si);
                const float nr = a.x * sr - a.y * si + er, ni = a.x * si + a.y * sr + ei; sr = nr; si = ni; }
            __syncthreads();
        }
        SEAM(5);
    }
    PHASE(6) { PHASE_VARS GemmToep g; g.Ug = (const char*)P.out; g.Sin = (const char*)(ws + OFF_SIN); g.Kc = (const char*)(ws + OFF_KC); g.Wc = (const char*)P.out + OUT_WC; g.gact = (bf16_t*)(ws + OFF_GACT); gemm_phase(lds, g, G, bx); SEAM(6); }
    PHASE(7) { PHASE_VARS GemmGLU g; g.A = (const char*)(ws + OFF_GACT); g.B = (const char*)(ws + OFF_WGLU); g.xb = xb; g.rowss = rowss; g.coef = LASTREP(7) ? 1.0f : 0.f; gemm_phase(lds, g, G, bx); SEAM(7); }
    PH_GU(8, 8, job_dn(P, 0, 1))
    PH_DN(9, job_gu(P, 1, 0))
    PH_GU(11, 4, job_dn(P, 1, 0))
    PH_DN(12, job_gu(P, 1, 1))
    PHASE(13) { PHASE_VARS
        bf16_t* pbuf = (bf16_t*)(ws + OFF_PBUF); const float* g1 = P.norm_g + (3 + 1) * D; float* rs = (float*)lds_raw;
        for (int ch = bx; ch < NCH; ch += G) {
            const int t0 = ch * 64; const int sbeg = t0 < TP ? 0 : TP + ((t0 - TP) / DSEQ) * DSEQ, send = t0 < TP ? TP : sbeg + DSEQ;
            if (tid < 80) { const int tok = t0 - 8 + tid; rs[tid] = (tok >= sbeg && tok < send) ? row_rstd(rowss, tok, 4) : 0.f; }
            __syncthreads();
            const int cq = tid & 255, half = tid >> 8, hw = 1 << (cq >> 6), ta = t0 + 32 * half;
            const f32x4 gv = *(const f32x4*)(g1 + cq * 4);
            f32x4 S = (f32x4){0.f, 0.f, 0.f, 0.f};
#define LDX(tok) ({ const u32x2 _q = *(const u32x2*)(xb + (size_t)(tok) * D + cq * 4); (f32x4){bf_lo(_q.x), bf_hi(_q.x), bf_lo(_q.y), bf_hi(_q.y)} * rs[(tok) - t0 + 8]; })
            for (int s = ta - hw; s <= ta + hw - 2; ++s) if (s >= sbeg && s < send) S += LDX(s);
            for (int t = ta; t < ta + 32; ++t) {
                const int sin_ = t + hw - 1; if (sin_ < send) S += LDX(sin_);
                const int wl = (t - hw) > sbeg ? (t - hw) : sbeg, wh = (t + hw) < send ? (t + hw) : send; const float inv = 1.0f / (float)(wh - wl);
                const f32x4 xt = LDX(t);
                const f32x4 pv = (S * inv - xt) * gv;
                u32x2 w; w.x = pk2(pv[0], pv[1]); w.y = pk2(pv[2], pv[3]); *(u32x2*)(pbuf + (size_t)t * D + cq * 4) = w;
                const int sout = t - hw; if (sout >= sbeg) S -= LDX(sout);
            }
#undef LDX
            __syncthreads();
        }
        SEAM(13);
    }
    PHASE(14) { PHASE_VARS GemmResid<D, 256, 4> g; g.cj = job_none(); g.A = (const char*)(ws + OFF_PBUF); g.B = (const char*)(ws + OFF_WPOOL); g.xb = xb; g.rowss = rowss; g.coef = LASTREP(14) ? 1.0f : 0.f; g.pool = 1; gemm_phase(lds, g, G, bx); SEAM(14); }
    PH_GU(15, 4, job_dn(P, 1, 1))
    PH_DN(16, job_none())
    PHASE(17) { PHASE_VARS
        f32x4 gv[4];
#pragma unroll
        for (int k = 0; k < 4; ++k) gv[k] = *(const f32x4*)(P.final_g + (k >> 1) * 512 + lane * 8 + (k & 1) * 4);
        for (int row = gw; row < T; row += 4 * NW) {
            u32x4 q[4][2];
#pragma unroll
            for (int r = 0; r < 4; ++r) { const int rr = (row + r * NW) < T ? (row + r * NW) : row;
#pragma unroll
                for (int k = 0; k < 2; ++k) q[r][k] = *(const u32x4*)(xb + (size_t)rr * D + k * 512 + lane * 8); }
#pragma unroll
            for (int r = 0; r < 4; ++r) { const int rr = (row + r * NW) < T ? (row + r * NW) : row; float* dst = x + (size_t)rr * D; f32x4 v[4]; float ss = 0.f;
#pragma unroll
                for (int k = 0; k < 2; ++k) { const u32x4 w = q[r][k];
                    v[2 * k] = (f32x4){bf_lo(w.x), bf_hi(w.x), bf_lo(w.y), bf_hi(w.y)}; v[2 * k + 1] = (f32x4){bf_lo(w.z), bf_hi(w.z), bf_lo(w.w), bf_hi(w.w)}; }
#pragma unroll
                for (int k = 0; k < 4; ++k) ss += (v[k][0] * v[k][0] + v[k][1] * v[k][1]) + (v[k][2] * v[k][2] + v[k][3] * v[k][3]);
                ss = wave_sum(ss); const float rs = __builtin_amdgcn_rsqf(ss * (1.0f / 1024.0f) + EPS);
#pragma unroll
                for (int k = 0; k < 4; ++k) *(f32x4*)(dst + (k >> 1) * 512 + lane * 8 + (k & 1) * 4) = v[k] * rs * gv[k]; }
        }
    }
#undef PHASE
#undef SEAM
}

extern "C" void kernel_launch(void* const* d_in, const int* in_sizes, int n_in, void* d_out, int out_size, void* d_ws, size_t ws_size, hipStream_t stream) {
    static int grid = 0;
    if (grid == 0) {
        int dev = 0, cus = 0, per_cu = 0;
        (void)hipGetDevice(&dev); (void)hipDeviceGetAttribute(&cus, hipDeviceAttributeMultiprocessorCount, dev);
        if (hipFuncSetAttribute((const void*)fwd_megakernel, hipFuncAttributeMaxDynamicSharedMemorySize, LDS_BYTES) != hipSuccess) fprintf(stderr, "kernel_launch: hipFuncSetAttribute failed\n");
        if (hipOccupancyMaxActiveBlocksPerMultiprocessor(&per_cu, (const void*)fwd_megakernel, 512, LDS_BYTES) != hipSuccess || per_cu < 1) { fprintf(stderr, "kernel_launch: occupancy query says %d\n", per_cu); per_cu = 1; }
        (void)hipGetLastError();
        grid = cus > 0 ? cus : 256;
        if (ws_size < WS_END) fprintf(stderr, "kernel_launch: workspace too small: %zu < %zu\n", ws_size, (size_t)WS_END);
    }
    Params p{};
    p.xin0 = (const float*)d_in[0]; p.xin1 = (const float*)d_in[1]; p.norm_g = (const float*)d_in[2]; p.final_g = (const float*)d_in[3];
    p.wg = (const float*)d_in[4]; p.wu = (const float*)d_in[5]; p.wd = (const float*)d_in[6];
    p.lam_re = (const float*)d_in[7]; p.lam_im = (const float*)d_in[8]; p.log_step = (const float*)d_in[9];
    p.b_re = (const float*)d_in[10]; p.b_im = (const float*)d_in[11]; p.c_re = (const float*)d_in[12]; p.c_im = (const float*)d_in[13];
    p.s5d = (const float*)d_in[14]; p.glu_a = (const float*)d_in[15]; p.glu_b = (const float*)d_in[16]; p.pool_w = (const float*)d_in[17]; p.pool_scale = (const float*)d_in[18];
    p.out = (float*)d_out; p.ws = (unsigned char*)d_ws;
#if ONE_LAUNCH
    (void)hipMemsetAsync((char*)d_ws + OFF_BAR, 0, XCD_BAR_WORDS * 4, stream);
    p.ph_lo = 0; p.ph_hi = NPHASE;
    void* args[] = {&p};
    hipError_t e = hipLaunchCooperativeKernel((const void*)fwd_megakernel, dim3(grid), dim3(512), args, LDS_BYTES, stream);
    if (e != hipSuccess) fprintf(stderr, "cooperative launch failed: %s (grid %d)\n", hipGetErrorString(e), grid);
#else
    for (int k = 0; k < NPHASE; ++k) { p.ph_lo = k; p.ph_hi = k + 1; hipLaunchKernelGGL(fwd_megakernel, dim3(grid), dim3(512), LDS_BYTES, stream, p); }
#endif
}
```
